# Optimizing an MI355X kernel written in HIP

```python
import math
import jax, jax.numpy as jnp
from jax import lax
import numpy as np

D_MODEL = 2048
BATCH = 4
SEQ = 2048
DEPTH = 4
DEC_BATCH = 128
DEC_SEQ = 4
PAST_LEN = 16384
PAGE_SIZE = 128

N_META = 16
CONV_K = 4
CHUNK = 64
MIX_W = D_MODEL
GROUP_W = MIX_W // 4
N_HEADS_GRP = 4
HEAD_V = GROUP_W // N_HEADS_GRP
DN_DK = HEAD_V
GLA_DK = HEAD_V // 2
RET_DK = HEAD_V // 2
GLA_RANK = 16
GLA_TAU = 16
LRU_BLOCKS = N_HEADS_GRP
LRU_C = 8
ROPE_BASE = 10000.0
EPS = 1e-6
DN_QKV_W = 3 * N_HEADS_GRP * DN_DK
IN_SIZES = (DN_QKV_W, N_HEADS_GRP, N_HEADS_GRP, GROUP_W,
            N_HEADS_GRP * GLA_DK, N_HEADS_GRP * GLA_DK, GROUP_W, GLA_RANK,
            N_HEADS_GRP * RET_DK, N_HEADS_GRP * RET_DK, GROUP_W, MIX_W)
IN_W = sum(IN_SIZES)

kernel_name = 'hymba_delta_lru_gla_retention_step'


def rms_norm(x, w=None):
    xf = x.astype(jnp.float32)
    y = xf * lax.rsqrt(jnp.mean(xf * xf, axis=-1, keepdims=True) + EPS)
    if w is not None:
        y = y * w.astype(jnp.float32)
    return y.astype(x.dtype)


def l2_normalize(x):
    return x * lax.rsqrt(jnp.sum(x * x, axis=-1, keepdims=True) + EPS)


def split_last(x, sizes):
    outs, off = [], 0
    for s in sizes:
        outs.append(x[..., off:off + s])
        off += s
    return outs


def causal_conv(x, buf, w):
    xp = jnp.concatenate([buf, x], axis=1)
    y = lax.conv_general_dilated(xp, w[:, None, :], window_strides=(1,), padding='VALID',
                                 dimension_numbers=('NWC', 'WIO', 'NWC'),
                                 feature_group_count=x.shape[-1])
    return y, xp[:, -(CONV_K - 1):]


def rotary(x, pos):
    half = x.shape[-1] // 2
    freqs = ROPE_BASE ** (-jnp.arange(half, dtype=jnp.float32) / half)
    ang = pos.astype(jnp.float32)[:, None] * freqs
    cos, sin = jnp.cos(ang)[None, :, None, :], jnp.sin(ang)[None, :, None, :]
    x1, x2 = x[..., :half], x[..., half:]
    return jnp.concatenate([x1 * cos - x2 * sin, x2 * cos + x1 * sin], axis=-1)


def to_chunks(x, c):
    b, l = x.shape[:2]
    return jnp.moveaxis(x.reshape(b, l // c, c, *x.shape[2:]), 1, 0)


def from_chunks(y):
    y = jnp.moveaxis(y, 0, 1)
    return y.reshape(y.shape[0], -1, *y.shape[3:])


def run_pieces(scan_fn, arrays, s0, pieces):
    outs, s = [], s0
    for start, stop, c in pieces:
        o, s = scan_fn(*[a[:, start:stop] for a in arrays], s, c)
        outs.append(o)
    return jnp.concatenate(outs, axis=1), s


def delta_chunk_scan(q, k, v, beta, g, s0, c):
    dv = v.shape[-1]
    incl = jnp.tril(jnp.ones((c, c), dtype=bool))
    strict = jnp.tril(jnp.ones((c, c), dtype=bool), -1)
    eye = jnp.eye(c, dtype=jnp.float32)

    def step(s, inp):
        qc, kc, vc, bc, gc = inp
        gcum = jnp.moveaxis(jnp.cumsum(gc, axis=1), 1, 2)
        decay = jnp.exp(jnp.where(incl, gcum[..., :, None] - gcum[..., None, :], -jnp.inf))
        kb = kc * bc[..., None]
        a = jnp.where(strict, jnp.einsum('bihk,bjhk->bhij', kb, kc) * decay, 0.0)
        rhs = jnp.concatenate([jnp.moveaxis(vc * bc[..., None], 1, 2),
                               jnp.moveaxis(kb, 1, 2) * jnp.exp(gcum)[..., None]], axis=-1)
        sol = lax.linalg.triangular_solve(a + eye, rhs, left_side=True, lower=True)
        u, w = sol[..., :dv], sol[..., dv:]
        v_new = u - jnp.einsum('bhik,bhkv->bhiv', w, s)
        attn = jnp.einsum('bihk,bjhk->bhij', qc, kc) * decay
        o = (jnp.einsum('bihk,bhi,bhkv->bihv', qc, jnp.exp(gcum), s)
             + jnp.einsum('bhij,bhjv->bihv', attn, v_new))
        g_last = gcum[..., -1]
        s_new = (s * jnp.exp(g_last)[..., None, None]
                 + jnp.einsum('bjhk,bhj,bhjv->bhkv', kc, jnp.exp(g_last[..., None] - gcum), v_new))
        return s_new, o

    s, o = lax.scan(step, s0, tuple(to_chunks(t, c) for t in (q, k, v, beta, g)))
    return from_chunks(o), s


def gla_chunk_scan(q, k, v, lg, s0, c):
    incl = jnp.tril(jnp.ones((c, c), dtype=bool))

    def step(s, inp):
        qc, kc, vc, lc = inp
        b = jnp.cumsum(lc, axis=1)
        rel = jnp.exp(jnp.where(incl[None, :, :, None, None], b[:, :, None] - b[:, None, :], -jnp.inf))
        attn = jnp.einsum('bihk,bjhk,bijhk->bhij', qc, kc, rel)
        o = (jnp.einsum('bihk,bhkv->bihv', qc * jnp.exp(b), s)
             + jnp.einsum('bhij,bjhv->bihv', attn, vc))
        b_last = b[:, -1]
        s_new = (s * jnp.exp(b_last)[..., None]
                 + jnp.einsum('bjhk,bjhv->bhkv', kc * jnp.exp(b_last[:, None] - b), vc))
        return s_new, o

    s, o = lax.scan(step, s0, tuple(to_chunks(t, c) for t in (q, k, v, lg)))
    return from_chunks(o), s


def retention_chunk_scan(q, k, v, s0, c, log_gamma):
    pos = jnp.arange(c, dtype=jnp.float32)
    rel = pos[:, None] - pos[None, :]
    intra = jnp.where(rel >= 0, jnp.exp(log_gamma[:, None, None] * jnp.maximum(rel, 0.0)), 0.0)
    from_state = jnp.exp(log_gamma[:, None] * (pos + 1.0))
    to_state = jnp.exp(log_gamma[:, None] * (c - 1.0 - pos))
    chunk_decay = jnp.exp(log_gamma * c)

    def step(s, inp):
        qc, kc, vc = inp
        attn = jnp.einsum('bihk,bjhk->bhij', qc, kc) * intra
        o = (jnp.einsum('bihk,hi,bhkv->bihv', qc, from_state, s)
             + jnp.einsum('bhij,bjhv->bihv', attn, vc))
        s_new = s * chunk_decay[:, None, None] + jnp.einsum('bjhk,hj,bjhv->bhkv', kc, to_state, vc)
        return s_new, o

    s, o = lax.scan(step, s0, tuple(to_chunks(t, c) for t in (q, k, v)))
    return from_chunks(o), s


def rg_lru(x, h0, wa, ba, wx, bx, lam):
    bsz, l, w = x.shape
    xb = x.reshape(bsz, l, LRU_BLOCKS, w // LRU_BLOCKS)
    r = jax.nn.sigmoid(jnp.einsum('blnc,ncd->blnd', xb, wa).reshape(bsz, l, w) + ba)
    i = jax.nn.sigmoid(jnp.einsum('blnc,ncd->blnd', xb, wx).reshape(bsz, l, w) + bx)
    log_a = -LRU_C * r * jax.nn.softplus(-lam)
    a = jnp.exp(log_a)
    b = jnp.sqrt(-jnp.expm1(2.0 * log_a)) * (i * x)
    b = b.at[:, 0].add(a[:, 0] * h0)

    def combine(left, right):
        return (left[0] * right[0], right[0] * left[1] + right[1])

    _, h = lax.associative_scan(combine, (a, b), axis=1)
    return h, h[:, -1]


def hybrid_layer(x, pos, pieces, s_delta, buf_delta, h_lru, buf_lru, s_gla, s_ret, lp):
    f32 = jnp.float32
    bsz, l, _ = x.shape
    nh = N_HEADS_GRP
    proj = jnp.einsum('bld,de->ble', rms_norm(x, lp['norm']), lp['w_in']).astype(f32)
    (qkv_a, alpha_a, beta_a, x_b, q_c, k_c, v_c, r_c, q_d, k_d, v_d, gate) = split_last(proj, IN_SIZES)

    qkv_a, new_buf_delta = causal_conv(qkv_a, buf_delta.astype(f32), lp['conv_a'].astype(f32))
    qkv_a = jax.nn.silu(qkv_a).reshape(bsz, l, 3, nh, DN_DK)
    q_a = l2_normalize(qkv_a[:, :, 0]) * (DN_DK ** -0.5)
    k_a = l2_normalize(qkv_a[:, :, 1])
    v_a = qkv_a[:, :, 2]
    beta = jax.nn.sigmoid(beta_a)
    g = -jnp.exp(lp['a_log'].astype(f32)) * jax.nn.softplus(alpha_a + lp['dt_bias'].astype(f32))
    o_a, new_s_delta = run_pieces(delta_chunk_scan, (q_a, k_a, v_a, beta, g), s_delta.astype(f32), pieces)
    o_a = rms_norm(o_a, lp['norm_a']).reshape(bsz, l, GROUP_W)

    x_b, new_buf_lru = causal_conv(x_b, buf_lru.astype(f32), lp['conv_b'].astype(f32))
    x_b = x_b + lp['conv_b_bias'].astype(f32)
    o_b, new_h_lru = rg_lru(x_b, h_lru.astype(f32), lp['lru_wa'].astype(f32), lp['lru_ba'].astype(f32),
                           lp['lru_wx'].astype(f32), lp['lru_bx'].astype(f32), lp['lru_lambda'].astype(f32))

    q_c = q_c.reshape(bsz, l, nh, GLA_DK) * (GLA_DK ** -0.5)
    k_c = k_c.reshape(bsz, l, nh, GLA_DK)
    v_c = v_c.reshape(bsz, l, nh, HEAD_V)
    lg_c = jax.nn.log_sigmoid(r_c @ lp['gla_w2'].astype(f32) + lp['gla_b2'].astype(f32))
    lg_c = lg_c.reshape(bsz, l, nh, GLA_DK) / GLA_TAU
    o_c, new_s_gla = run_pieces(gla_chunk_scan, (q_c, k_c, v_c, lg_c), s_gla.astype(f32), pieces)
    o_c = rms_norm(o_c, lp['norm_c']).reshape(bsz, l, GROUP_W)

    q_d = rotary(q_d.reshape(bsz, l, nh, RET_DK), pos)
    k_d = rotary(k_d.reshape(bsz, l, nh, RET_DK), pos) * (RET_DK ** -0.5)
    v_d = v_d.reshape(bsz, l, nh, HEAD_V)
    log_gamma = jnp.log(1.0 - 2.0 ** (-5.0 - jnp.arange(nh, dtype=f32)))
    ret_fn = lambda q, k, v, s, c: retention_chunk_scan(q, k, v, s, c, log_gamma)
    o_d, new_s_ret = run_pieces(ret_fn, (q_d, k_d, v_d), s_ret.astype(f32), pieces)
    o_d = rms_norm(o_d).reshape(bsz, l, GROUP_W)

    mixed = jnp.concatenate([o_a, o_b, o_c, o_d], axis=-1) * jax.nn.silu(gate)
    y = x + jnp.einsum('ble,ed->bld', mixed.astype(x.dtype), lp['w_out'])
    return y, (new_s_delta, new_buf_delta, new_h_lru, new_buf_lru, new_s_gla, new_s_ret)


def setup_inputs(seed: int = 0) -> dict:
    key = jax.random.key(seed)
    ks = jax.random.split(key, 32)
    f32 = jnp.float32
    nh = N_HEADS_GRP
    bw = GROUP_W // LRU_BLOCKS

    def nrm(k, shape, s):
        return s * jax.random.normal(k, shape, f32)

    a_log = jnp.log(jax.random.uniform(ks[10], (DEPTH, nh), f32, 1.0, 16.0))
    dt = jnp.exp(jax.random.uniform(ks[11], (DEPTH, nh), f32, math.log(1e-3), math.log(0.1)))
    dt_bias = dt + jnp.log(-jnp.expm1(-dt))
    a0 = jax.random.uniform(ks[12], (DEPTH, GROUP_W), f32, 0.9, 0.999) ** (1.0 / LRU_C)
    lru_lambda = jnp.log(a0) - jnp.log1p(-a0)
    return {
        'x_prompt': nrm(ks[0], (BATCH, SEQ, D_MODEL), 1.0),
        'x_sample': nrm(ks[1], (DEC_BATCH, DEC_SEQ, D_MODEL), 1.0),
        'state_delta': nrm(ks[2], (DEPTH, DEC_BATCH, nh, DN_DK, HEAD_V), 0.1),
        'state_delta_conv': nrm(ks[3], (DEPTH, DEC_BATCH, CONV_K - 1, DN_QKV_W), 1.0),
        'state_lru': nrm(ks[4], (DEPTH, DEC_BATCH, GROUP_W), 0.5),
        'state_lru_conv': nrm(ks[5], (DEPTH, DEC_BATCH, CONV_K - 1, GROUP_W), 1.0),
        'state_gla': nrm(ks[6], (DEPTH, DEC_BATCH, nh, GLA_DK, HEAD_V), 0.5),
        'state_ret': nrm(ks[7], (DEPTH, DEC_BATCH, nh, RET_DK, HEAD_V), 0.5),
        'meta_tokens': nrm(ks[8], (N_META, D_MODEL), 1.0),
        'norm_w': 1.0 + nrm(ks[9], (DEPTH, D_MODEL), 0.01),
        'w_in': nrm(ks[13], (DEPTH, D_MODEL, IN_W), D_MODEL ** -0.5),
        'conv_a': nrm(ks[14], (DEPTH, CONV_K, DN_QKV_W), CONV_K ** -0.5),
        'a_log': a_log,
        'dt_bias': dt_bias,
        'norm_a': 1.0 + nrm(ks[15], (DEPTH, HEAD_V), 0.01),
        'conv_b': nrm(ks[16], (DEPTH, CONV_K, GROUP_W), CONV_K ** -0.5),
        'conv_b_bias': nrm(ks[17], (DEPTH, GROUP_W), 0.01),
        'lru_wa': nrm(ks[18], (DEPTH, LRU_BLOCKS, bw, bw), bw ** -0.5),
        'lru_ba': nrm(ks[19], (DEPTH, GROUP_W), 0.01),
        'lru_wx': nrm(ks[20], (DEPTH, LRU_BLOCKS, bw, bw), bw ** -0.5),
        'lru_bx': nrm(ks[21], (DEPTH, GROUP_W), 0.01),
        'lru_lambda': lru_lambda,
        'gla_w2': nrm(ks[22], (DEPTH, GLA_RANK, nh * GLA_DK), GLA_RANK ** -0.5),
        'gla_b2': nrm(ks[23], (DEPTH, nh * GLA_DK), 0.01),
        'norm_c': 1.0 + nrm(ks[24], (DEPTH, HEAD_V), 0.01),
        'w_out': nrm(ks[25], (DEPTH, MIX_W, D_MODEL), 0.5 * MIX_W ** -0.5),
        'final_norm': 1.0 + nrm(ks[26], (D_MODEL,), 0.01),
    }


def reference(x_prompt, x_sample, state_delta, state_delta_conv, state_lru, state_lru_conv, state_gla,
              state_ret, meta_tokens, norm_w, w_in, conv_a, a_log, dt_bias, norm_a, conv_b, conv_b_bias,
              lru_wa, lru_ba, lru_wx, lru_bx, lru_lambda, gla_w2, gla_b2, norm_c, w_out, final_norm):
    f32 = jnp.float32
    nh = N_HEADS_GRP
    bp, lp_len = x_prompt.shape[0], x_prompt.shape[1]
    ls = x_sample.shape[1]
    meta = jnp.broadcast_to(meta_tokens[None].astype(x_prompt.dtype), (bp, N_META, D_MODEL))
    hp = jnp.concatenate([meta, x_prompt], axis=1)
    hs = x_sample
    pos_p = jnp.arange(N_META + lp_len)
    pos_s = PAST_LEN + jnp.arange(ls)
    pieces_p = ((0, N_META, N_META), (N_META, N_META + lp_len, math.gcd(lp_len, CHUNK)))
    pieces_s = ((0, ls, math.gcd(ls, CHUNK)),)

    p_states, s_states = [], []
    for layer in range(DEPTH):
        lp = {'norm': norm_w[layer], 'w_in': w_in[layer], 'conv_a': conv_a[layer], 'a_log': a_log[layer],
              'dt_bias': dt_bias[layer], 'norm_a': norm_a[layer], 'conv_b': conv_b[layer],
              'conv_b_bias': conv_b_bias[layer], 'lru_wa': lru_wa[layer], 'lru_ba': lru_ba[layer],
              'lru_wx': lru_wx[layer], 'lru_bx': lru_bx[layer], 'lru_lambda': lru_lambda[layer],
              'gla_w2': gla_w2[layer], 'gla_b2': gla_b2[layer], 'norm_c': norm_c[layer], 'w_out': w_out[layer]}
        hp, st_p = hybrid_layer(
            hp, pos_p, pieces_p,
            jnp.zeros((bp, nh, DN_DK, HEAD_V), f32), jnp.zeros((bp, CONV_K - 1, DN_QKV_W), f32),
            jnp.zeros((bp, GROUP_W), f32), jnp.zeros((bp, CONV_K - 1, GROUP_W), f32),
            jnp.zeros((bp, nh, GLA_DK, HEAD_V), f32), jnp.zeros((bp, nh, RET_DK, HEAD_V), f32), lp)
        hs, st_s = hybrid_layer(
            hs, pos_s, pieces_s, state_delta[layer], state_delta_conv[layer], state_lru[layer],
            state_lru_conv[layer], state_gla[layer], state_ret[layer], lp)
        p_states.append(st_p)
        s_states.append(st_s)

    p_delta, p_delta_conv, p_lru, p_lru_conv, p_gla, p_ret = [
        jnp.stack([st[i] for st in p_states]) for i in range(6)]
    s_delta, s_delta_conv, s_lru, s_lru_conv, s_gla, s_ret = [
        jnp.stack([st[i] for st in s_states]) for i in range(6)]
    y_prompt = rms_norm(hp, final_norm)[:, N_META:]
    y_sample = rms_norm(hs, final_norm)
    return (y_prompt, y_sample, p_delta, p_delta_conv, p_lru, p_lru_conv, p_gla, p_ret,
            s_delta, s_delta_conv, s_lru, s_lru_conv, s_gla, s_ret)
```

```cpp
#include <hip/hip_runtime.h>
#include <hip/hip_bf16.h>
#include <hip/hip_cooperative_groups.h>
#include <cstdio>
namespace cg = cooperative_groups;

using bf16 = __hip_bfloat16;
using bf16x8 = __attribute__((ext_vector_type(8))) short;
using f32x4 = __attribute__((ext_vector_type(4))) float;

constexpr int D = 2048;
constexpr int LP = 2064;
constexpr int NPR = 4 * LP;
constexpr int NSR = 512;
constexpr int MROWS = NPR + NSR;
constexpr int MPAD = 8960;
constexpr int INW = 6168;
constexpr int LDW = 6400;
constexpr int LDP = 4352;
constexpr int GCOL0 = 4352;
constexpr int NTHR = 512;
constexpr int LDS_BYTES = 131072 + 64;

constexpr int C_ALPHA = 1536, C_BETA = 1540, C_XB = 1544, C_QC = 2056, C_KC = 2312, C_VC = 2568, C_RC = 3080,
              C_QD = 3096, C_KD = 3352, C_VD = 3608, C_GATE = 4120;
constexpr int P_QA = 0, P_KA = 512, P_VA = 1024, P_AB = 1536, P_LA = 1544, P_LB = 2056, P_QC = 2568, P_KC = 2824,
              P_AC = 3080, P_QD = 3336, P_KD = 3592, P_WA = 3848, P_KH = 4360, P_GC = 4872, P_DM = 4880, PREP_LD = 4944;

constexpr size_t O_YP = 0;
constexpr size_t O_YS = O_YP + (size_t)4 * 2048 * 2048;
constexpr size_t O_PD = O_YS + (size_t)128 * 4 * 2048;
constexpr size_t O_PDC = O_PD + (size_t)4 * 4 * 4 * 128 * 128;
constexpr size_t O_PL = O_PDC + (size_t)4 * 4 * 3 * 1536;
constexpr size_t O_PLC = O_PL + (size_t)4 * 4 * 512;
constexpr size_t O_PG = O_PLC + (size_t)4 * 4 * 3 * 512;
constexpr size_t O_PR = O_PG + (size_t)4 * 4 * 4 * 64 * 128;
constexpr size_t O_SD = O_PR + (size_t)4 * 4 * 4 * 64 * 128;
constexpr size_t O_SDC = O_SD + (size_t)4 * 128 * 4 * 128 * 128;
constexpr size_t O_SL = O_SDC + (size_t)4 * 128 * 3 * 1536;
constexpr size_t O_SLC = O_SL + (size_t)4 * 128 * 512;
constexpr size_t O_SG = O_SLC + (size_t)4 * 128 * 3 * 512;
constexpr size_t O_SR = O_SG + (size_t)4 * 128 * 4 * 64 * 128;

constexpr size_t WS_WTIN = 0;
constexpr size_t WS_WTOUT = WS_WTIN + (size_t)4 * LDW * 2048 * 2;
constexpr size_t WS_H = WS_WTOUT + (size_t)4 * 2048 * 2048 * 2;
constexpr size_t WS_XN = WS_H + (size_t)MPAD * 2048 * 4;
constexpr size_t WS_PROJ = WS_XN + (size_t)MPAD * 2048 * 2;
constexpr size_t WS_PREP = WS_PROJ + (size_t)MPAD * LDP * 4;
constexpr size_t WS_OBUF = WS_PREP + (size_t)MROWS * PREP_LD * 4;
constexpr size_t WS_MIX = WS_XN;
constexpr size_t WS_WTG = WS_OBUF + (size_t)MROWS * 2048 * 4;
constexpr size_t WS_GDEC = WS_WTG + (size_t)4 * 4 * 2 * 128 * 128 * 2;
constexpr size_t WS_BAR = WS_GDEC + (size_t)(MROWS / 16) * 256 * 4;
constexpr size_t WS_PB = WS_BAR + 16384;
constexpr size_t WS_GB16 = WS_PB + (size_t)24 * 8 * 65536 * 4;
constexpr size_t WS_END = WS_GB16 + (size_t)MPAD * 2048 * 2;

struct P { const float* in[27]; float* out; unsigned char* ws; int mpad, ldp, dm, pad, ldq, pad2; };
typedef const __attribute__((address_space(4))) P CP;
__device__ __forceinline__ CP* getp() { CP* pp = (CP*)__builtin_amdgcn_kernarg_segment_ptr(); asm volatile("" : "+s"(pp)); return pp; }

__device__ __forceinline__ unsigned short f2bf(float f) {
  unsigned u = __float_as_uint(f);
  u += 0x7fffu + ((u >> 16) & 1u);
  return (unsigned short)(u >> 16);
}
typedef float cvf2_t __attribute__((ext_vector_type(2)));
typedef __bf16 cvb2_t __attribute__((ext_vector_type(2)));
__device__ __forceinline__ unsigned cvtpk(float lo, float hi) { cvf2_t v = {lo, hi}; return __builtin_bit_cast(unsigned, __builtin_convertvector(v, cvb2_t)); }
__device__ __forceinline__ unsigned pack2(float a, float b) { return (unsigned)f2bf(a) | ((unsigned)f2bf(b) << 16); }
__device__ __forceinline__ float sigmoidf_(float x) { return 1.f / (1.f + __expf(-x)); }
__device__ __forceinline__ float siluf_(float x) { return x / (1.f + __expf(-x)); }
__device__ __forceinline__ float softplusf_(float x) {
  const float e = __expf(fminf(x, 15.f));
  const float mid = __logf(1.f + e);
  return x > 15.f ? x : (x < -6.f ? e * (1.f - 0.5f * e) : mid);
}
template <int CTRL> __device__ __forceinline__ float dpp_f(float x) {
  return __builtin_bit_cast(float, __builtin_amdgcn_update_dpp(0, __builtin_bit_cast(int, x), CTRL, 0xf, 0xf, true));
}

typedef __attribute__((ext_vector_type(4))) unsigned u32x4;
__device__ __forceinline__ bf16x8 mkfrag(unsigned a, unsigned b, unsigned c, unsigned d) { u32x4 t = {a, b, c, d}; return __builtin_bit_cast(bf16x8, t); }
__device__ __forceinline__ float row16_allsum(float x) {
  x += dpp_f<0x128>(x);
  x += dpp_f<0x124>(x);
  x += dpp_f<0x122>(x);
  x += dpp_f<0x121>(x);
  return x;
}
__device__ __forceinline__ float wave_allsum(float x) {
  x = row16_allsum(x);
  const int xi = __builtin_bit_cast(int, x);
  const float r0 = __builtin_bit_cast(float, __builtin_amdgcn_readlane(xi, 0));
  const float r1 = __builtin_bit_cast(float, __builtin_amdgcn_readlane(xi, 16));
  const float r2 = __builtin_bit_cast(float, __builtin_amdgcn_readlane(xi, 32));
  const float r3 = __builtin_bit_cast(float, __builtin_amdgcn_readlane(xi, 48));
  return (r0 + r1) + (r2 + r3);
}

__device__ __forceinline__ int opaque_tid(int wv) { unsigned m = ~0u; asm volatile("" : "+s"(m)); int t = wv * 64 + (int)__builtin_amdgcn_mbcnt_hi(m, __builtin_amdgcn_mbcnt_lo(m, 0u)); asm volatile("" : "+v"(t)); return t; }

constexpr int CV_TIN = 32 * 100, CV_TOUT = 32 * 32, CV_TL = CV_TIN + CV_TOUT;
__device__ __forceinline__ void convert_weights(CP& p, int wv, int t_lo, int t_hi, int bidx, int nb) {
  extern __shared__ __attribute__((aligned(16))) unsigned char smem_raw[];
  float* sm = (float*)smem_raw;
  const int tid = opaque_tid(wv);
  bf16* wtin = (bf16*)(p.ws + WS_WTIN);
  bf16* wtout = (bf16*)(p.ws + WS_WTOUT);
  constexpr int TIN = CV_TIN, TL = CV_TL;
  {
    const int kk0 = tid >> 4, n4 = (tid & 15) * 4;
    const int nn = tid >> 3, k8 = (tid & 7) * 8;
    float4 va = make_float4(0.f, 0.f, 0.f, 0.f), vb = va; float sa = 1.f, sb = 1.f;
#define CV_DECODE(t_) \
    const int l_ = (t_) / TL; int r_ = (t_) % TL; const float* src_; int nsrc_, kt_, nt_; const float* nw_; unsigned short* dst_; \
    if (r_ < TIN) { kt_ = r_ / 100; nt_ = r_ % 100; src_ = p.in[10] + (size_t)l_ * 2048 * INW; nsrc_ = INW; \
                    dst_ = (unsigned short*)(wtin + (size_t)l_ * LDW * 2048); nw_ = p.in[9] + l_ * 2048; } \
    else { r_ -= TIN; kt_ = r_ / 32; nt_ = r_ % 32; src_ = p.in[25] + (size_t)l_ * 2048 * 2048; nsrc_ = 2048; \
           dst_ = (unsigned short*)(wtout + (size_t)l_ * 2048 * 2048); nw_ = nullptr; }
#define CV_LOAD(t_) do { CV_DECODE(t_) (void)dst_; \
      const int n_ = nt_ * 64 + n4, ka_ = kt_ * 64 + kk0, kb_ = ka_ + 32; \
      va = make_float4(0.f, 0.f, 0.f, 0.f); vb = va; \
      if (n_ < nsrc_) { va = *(const float4*)(src_ + (size_t)ka_ * nsrc_ + n_); vb = *(const float4*)(src_ + (size_t)kb_ * nsrc_ + n_); } \
      sa = nw_ ? nw_[ka_] : 1.f; sb = nw_ ? nw_[kb_] : 1.f; } while (0)
    int t = t_lo + bidx;
    if (t < t_hi) CV_LOAD(t);
    int cur = 0;
    for (; t < t_hi; t += nb) {
      float* sb_ = sm + cur * (64 * 65);
      sb_[kk0 * 65 + n4 + 0] = va.x * sa; sb_[kk0 * 65 + n4 + 1] = va.y * sa; sb_[kk0 * 65 + n4 + 2] = va.z * sa; sb_[kk0 * 65 + n4 + 3] = va.w * sa;
      sb_[(kk0 + 32) * 65 + n4 + 0] = vb.x * sb; sb_[(kk0 + 32) * 65 + n4 + 1] = vb.y * sb; sb_[(kk0 + 32) * 65 + n4 + 2] = vb.z * sb; sb_[(kk0 + 32) * 65 + n4 + 3] = vb.w * sb;
      if (t + nb < t_hi) CV_LOAD(t + nb);
      __syncthreads();
      {
        CV_DECODE(t) (void)src_; (void)nsrc_; (void)nw_;
        uint4 o;
        o.x = pack2(sb_[(k8 + 0) * 65 + nn], sb_[(k8 + 1) * 65 + nn]);
        o.y = pack2(sb_[(k8 + 2) * 65 + nn], sb_[(k8 + 3) * 65 + nn]);
        o.z = pack2(sb_[(k8 + 4) * 65 + nn], sb_[(k8 + 5) * 65 + nn]);
        o.w = pack2(sb_[(k8 + 6) * 65 + nn], sb_[(k8 + 7) * 65 + nn]);
        *(uint4*)(dst_ + (size_t)(nt_ * 64 + nn) * 2048 + kt_ * 64 + k8) = o;
      }
      cur ^= 1;
    }
#undef CV_LOAD
#undef CV_DECODE
    __syncthreads();
  }
}

__device__ __forceinline__ void phase_convert(CP& p, int wv) {
  const int tid = opaque_tid(wv);
  convert_weights(p, wv, 0, CV_TL, blockIdx.x, gridDim.x);
  float* H = (float*)(p.ws + WS_H);
  const size_t gtid = (size_t)blockIdx.x * NTHR + tid, gsz = (size_t)gridDim.x * NTHR;
  for (size_t idx = gtid; idx < (size_t)MPAD * 512; idx += gsz) {
    const int r = (int)(idx >> 9), c4 = (int)(idx & 511) * 4;
    float4 v = make_float4(0.f, 0.f, 0.f, 0.f);
    if (r < NPR) { const int b = r / LP, t = r % LP;
      v = t < 16 ? *(const float4*)(p.in[8] + (size_t)t * D + c4) : *(const float4*)(p.in[0] + ((size_t)b * 2048 + (t - 16)) * D + c4); }
    else if (r < MROWS) v = *(const float4*)(p.in[1] + (size_t)(r - NPR) * D + c4);
    *(float4*)(H + (size_t)r * D + c4) = v;
  }
  {
    unsigned short* wtg = (unsigned short*)(p.ws + WS_WTG);
    for (size_t idx = gtid; idx < (size_t)4 * 4 * 2 * 128 * 128; idx += gsz) {
      const int c = (int)(idx & 127), d = (int)((idx >> 7) & 127), g = (int)((idx >> 14) & 1), blk = (int)((idx >> 15) & 3), l = (int)(idx >> 17);
      const float* srcg = (g == 0 ? p.in[17] : p.in[19]) + ((size_t)((l * 4 + blk) * 128 + c)) * 128 + d;
      wtg[idx] = f2bf(*srcg);
    }
  }
  unsigned* mixz = (unsigned*)(p.ws + WS_MIX + (size_t)MROWS * 2048 * 2);
  for (size_t idx = gtid; idx < (size_t)(MPAD - MROWS) * 1024; idx += gsz) mixz[idx] = 0u;
}

__device__ __forceinline__ void phase_norm(CP& p, int wv, int fix) {
  const int tid = opaque_tid(wv), lane = tid & 63, w = tid >> 6;
  float* H = (float*)(p.ws + WS_H);
  const float* PB = (const float*)(p.ws + WS_PB);
  unsigned short* XN = (unsigned short*)(p.ws + WS_XN);
  for (int r = blockIdx.x * 8 + w; r < MPAD; r += gridDim.x * 8) {
    uint2* dst = (uint2*)(XN + (size_t)r * D);
    if (r >= MROWS) {
#pragma unroll
      for (int i = 0; i < 8; ++i) dst[lane + 64 * i] = make_uint2(0u, 0u);
      continue;
    }
    float4* src = (float4*)(H + (size_t)r * D);
    float4 v[8]; float ss = 0.f;
#pragma unroll
    for (int i = 0; i < 8; ++i) v[i] = src[lane + 64 * i];
    if (fix && r >= 8192) {
      const float* pb = PB + ((size_t)(((r >> 8) - 32) * 8) * 8) * 65536 + (size_t)(r & 255) * 256 + lane * 4;
#pragma unroll
      for (int i = 0; i < 8; ++i) {
#pragma unroll
        for (int ch = 0; ch < 8; ++ch) { const float4 a = *(const float4*)(pb + (size_t)(i * 8 + ch) * 65536); v[i].x += a.x; v[i].y += a.y; v[i].z += a.z; v[i].w += a.w; }
        src[lane + 64 * i] = v[i];
      }
    }
#pragma unroll
    for (int i = 0; i < 8; ++i) ss += v[i].x * v[i].x + v[i].y * v[i].y + v[i].z * v[i].z + v[i].w * v[i].w;
    ss = wave_allsum(ss);
    const float sc = rsqrtf(ss * (1.f / 2048.f) + 1e-6f);
#pragma unroll
    for (int i = 0; i < 8; ++i) dst[lane + 64 * i] = make_uint2(pack2(v[i].x * sc, v[i].y * sc), pack2(v[i].z * sc, v[i].w * sc));
  }
}

constexpr int BM = 256, BK = 64, HALF = 128, NXCD = 8, WGM = 8, HT = HALF * BK;
__device__ __forceinline__ int lds_byte(int r, int c) {
  int st = (r >> 4) * 2 + (c >> 5), rr = r & 15, cc = c & 31, ob = rr * 64 + cc * 2;
  return st * 1024 + (ob ^ (((ob >> 9) & 1) << 5));
}
__device__ __forceinline__ void stage_rc(int b, int& R, int& C) {
  int st = b / 1024, sb = b % 1024, swz = sb ^ (((sb >> 9) & 1) << 5);
  R = (st >> 1) * 16 + swz / 64; C = (st & 1) * 32 + (swz % 64) / 2;
}

template <int MODE> __device__ __forceinline__ void gemm_tile(const bf16*A,const bf16*Bt,float*C,int M,int N,int tile,int wv,int pmo,int pno,int kt0,int ntk,int ldc,int cpart,unsigned short*C16=nullptr){ constexpr int K=2048;
  extern __shared__ __attribute__((aligned(16))) bf16 shm[];
  const int tix = opaque_tid(wv);
  #define SA(b,h) (shm+((b)*2+(h))*HT)
  #define SB(b,h) (shm+(4+(b)*2+(h))*HT)
  unsigned soff0,soff1; {int _r,_c; stage_rc(tix*16,_r,_c); soff0=_r*K+_c; stage_rc(tix*16+8192,_r,_c); soff1=_r*K+_c;}
  #define STAGE(P,BASE,br,kt) do{const bf16* _gb=BASE+(long)(br)*K+(long)((kt)+kt0)*BK; \
      __builtin_amdgcn_global_load_lds((const unsigned*)(_gb+soff0),(unsigned*)((char*)(P)+tix*16),16,0,0); \
      __builtin_amdgcn_global_load_lds((const unsigned*)(_gb+soff1),(unsigned*)((char*)(P)+tix*16+8192),16,0,0);}while(0)
  #define LDA(dst,b,h) for(int m=0;m<4;++m)for(int k=0;k<2;++k) \
    dst[m][k]=*reinterpret_cast<const bf16x8*>((char*)SA(b,h)+lds_byte(wr*64+m*16+fr,k*32+fq*8))
  #define LDB(dst,b,h) for(int n=0;n<2;++n)for(int k=0;k<2;++k) \
    dst[n][k]=*reinterpret_cast<const bf16x8*>((char*)SB(b,h)+lds_byte(wc*32+n*16+fr,k*32+fq*8))
  #define MMA(ai,bj,At,Bt) do{__builtin_amdgcn_s_setprio(1); \
    for(int m=0;m<4;++m)for(int n=0;n<2;++n)for(int k=0;k<2;++k) \
      acc[ai][bj][m][n]=__builtin_amdgcn_mfma_f32_16x16x32_bf16(At[m][k],Bt[n][k],acc[ai][bj][m][n],0,0,0); \
    __builtin_amdgcn_s_setprio(0);}while(0)
  #define WAIT_V(n) asm volatile("s_waitcnt vmcnt(" #n ")":::"memory")
  #define WAIT_L(n) asm volatile("s_waitcnt lgkmcnt(" #n ")":::"memory")
  #define BAR __builtin_amdgcn_s_barrier()
  #define SCHED __builtin_amdgcn_sched_barrier(0)

  int nM=M/BM,nN=N/BM,nwg=nM*nN,wgid=tile;
  {int q=nwg/NXCD,r=nwg%NXCD,xcd=wgid%NXCD,off=wgid/NXCD;
   wgid=(xcd<r?xcd*(q+1):r*(q+1)+(xcd-r)*q)+off;}
  int nig=WGM*nN,gid=wgid/nig,fm=gid*WGM,gsz=min(nM-fm,WGM);
  int pm=fm+((wgid%nig)%gsz),pn=(wgid%nig)/gsz; if(pmo>=0){pm=pmo;pn=pno;} int brow=pm*BM,bcol=pn*BM;
  int wid=tix>>6,lane=tix&63,wr=wid>>2,wc=wid&3,fr=lane&15,fq=lane>>4;
  f32x4 acc[2][2][4][2]={};
  bf16x8 At[4][2],B0[2][2],B1[2][2];
  int nt=ntk;
  STAGE(SB(0,0),Bt,bcol,0); STAGE(SA(0,0),A,brow,0);
  STAGE(SB(0,1),Bt,bcol+HALF,0); STAGE(SA(0,1),A,brow+HALF,0);
  if(wr==1)BAR;
  WAIT_V(4); BAR;
  STAGE(SB(1,0),Bt,bcol,1); STAGE(SA(1,0),A,brow,1); STAGE(SB(1,1),Bt,bcol+HALF,1);
  WAIT_V(6); BAR;
  for(int t=0;t<nt-2;t+=2){
    LDB(B0,0,0); SCHED; LDA(At,0,0); STAGE(SA(1,1),A,brow+HALF,t+1);
    WAIT_L(8); BAR; WAIT_L(0); MMA(0,0,At,B0); BAR; SCHED;
    LDB(B1,0,1); STAGE(SB(0,0),Bt,bcol,t+2);
    BAR; WAIT_L(0); MMA(0,1,At,B1); BAR;
    LDA(At,0,1); STAGE(SA(0,0),A,brow,t+2);
    BAR; WAIT_L(0); MMA(1,0,At,B0); BAR; SCHED;
    STAGE(SB(0,1),Bt,bcol+HALF,t+2);
    WAIT_V(6); BAR; MMA(1,1,At,B1); BAR;
    LDB(B0,1,0); SCHED; LDA(At,1,0); STAGE(SA(0,1),A,brow+HALF,t+2);
    WAIT_L(8); BAR; WAIT_L(0); MMA(0,0,At,B0); BAR; SCHED;
    LDB(B1,1,1); STAGE(SB(1,0),Bt,bcol,t+3);
    BAR; WAIT_L(0); MMA(0,1,At,B1); BAR;
    LDA(At,1,1); STAGE(SA(1,0),A,brow,t+3);
    BAR; WAIT_L(0); MMA(1,0,At,B0); BAR; SCHED;
    STAGE(SB(1,1),Bt,bcol+HALF,t+3);
    WAIT_V(6); BAR; MMA(1,1,At,B1); BAR;
  }
  { LDB(B0,0,0); LDA(At,0,0); STAGE(SA(1,1),A,brow+HALF,nt-1);
    BAR; WAIT_L(0); MMA(0,0,At,B0); BAR;
    LDB(B1,0,1); BAR; WAIT_L(0); MMA(0,1,At,B1); BAR;
    LDA(At,0,1); WAIT_V(4); BAR; WAIT_L(0); MMA(1,0,At,B0); MMA(1,1,At,B1); BAR; }
  { LDB(B0,1,0); LDA(At,1,0); WAIT_V(2); BAR; WAIT_L(0); MMA(0,0,At,B0); BAR;
    LDB(B1,1,1); WAIT_V(0); BAR; WAIT_L(0); MMA(0,1,At,B1); BAR;
    LDA(At,1,1); BAR; WAIT_L(0); MMA(1,0,At,B0); MMA(1,1,At,B1); BAR; }
  if(wr==0)BAR;
  {
    float* eps = (float*)shm;
    const int er = tix >> 5, ec = (tix & 31) * 4;
    float* cbase = C + (long)((cpart ? 0 : brow) + er) * ldc + ((cpart ? 0 : bcol) + ec);
#pragma unroll
    for (int ai = 0; ai < 2; ++ai)
#pragma unroll
      for (int bj = 0; bj < 2; ++bj) {
        __syncthreads();
#pragma unroll
        for (int m = 0; m < 4; ++m)
#pragma unroll
          for (int n = 0; n < 2; ++n)
#pragma unroll
            for (int j = 0; j < 4; ++j) eps[(wr * 64 + m * 16 + fq * 4 + j) * 132 + wc * 32 + n * 16 + fr] = acc[ai][bj][m][n][j];
        __syncthreads();
        if (MODE == 0 && C16 != nullptr && pn >= 17) {
#pragma unroll
          for (int i = 0; i < 8; ++i) {
            const float4 v = *(const float4*)(eps + (er + 16 * i) * 132 + ec);
            uint2 o; o.x = cvtpk(v.x, v.y); o.y = cvtpk(v.z, v.w);
            *(uint2*)(C16 + (long)(brow + er + ai * HALF + 16 * i) * 2048 + ((pn - 17) * 256 + bj * HALF + ec)) = o;
          }
        } else {
#pragma unroll
          for (int i = 0; i < 8; ++i) {
            float4 v = *(const float4*)(eps + (er + 16 * i) * 132 + ec);
            float4* gp = (float4*)(cbase + (long)(ai * HALF + 16 * i) * ldc + bj * HALF);
            if (MODE == 1) { const float4 o = *gp; v.x += o.x; v.y += o.y; v.z += o.z; v.w += o.w; }
            *gp = v;
          }
        }
      }
    __syncthreads();
  }
}
#undef SA
#undef SB
#undef STAGE
#undef LDA
#undef LDB
#undef MMA
template <int MODE> __device__ __forceinline__ void phase_gemm(const bf16* A, const bf16* Bt, float* C, int M, int N, int wv, int ldc, unsigned short* C16) {
  const int nwg = (M / 256) * (N / 256);
  for (int t = blockIdx.x; t < nwg; t += gridDim.x) gemm_tile<MODE>(A, Bt, C, M, N, t, wv, -1, 0, 0, 32, ldc, 0, C16);
  __syncthreads();
}

__device__ __forceinline__ void phase_gemm_out(const bf16* A, const bf16* Bt, float* H, float* PB, int M, int N, int wv) {
#pragma unroll 1
  for (int t = blockIdx.x; t < 256; t += gridDim.x) gemm_tile<1>(A, Bt, H, M, N, t, wv, t >> 3, t & 7, 0, 32, N, 0);
#pragma unroll 1
  for (int i = blockIdx.x; i < 192; i += gridDim.x) {
    const int lt = i >> 3, ch = i & 7;
    gemm_tile<0>(A, Bt, PB + (size_t)i * 65536, M, N, 0, wv, 32 + (lt >> 3), lt & 7, ch * 4, 4, 256, 1);
  }
  __syncthreads();
}

__device__ __forceinline__ void phase_prep(CP& p, int l, int wv) {
  extern __shared__ __attribute__((aligned(16))) unsigned char smem_raw[];
  float* xs_t = (float*)smem_raw;
  unsigned short* xs16 = (unsigned short*)(smem_raw + 40960);
  float* gl = (float*)(smem_raw + 57600);
  const unsigned short* wtg = (const unsigned short*)(p.ws + WS_WTG);
  const int tid = opaque_tid(wv), lane = tid & 63, w = tid >> 6;
  const float* proj = (const float*)(p.ws + WS_PROJ);
  float* prep = (float*)(p.ws + WS_PREP);
  const float* conv_a = p.in[11] + (size_t)l * 4 * 1536;
  const float* cst_a = p.in[3] + (size_t)l * 128 * 3 * 1536;
  const float* conv_b = p.in[15] + (size_t)l * 4 * 512;
  const float* cbb = p.in[16] + (size_t)l * 512;
  const float* cst_b = p.in[5] + (size_t)l * 128 * 3 * 512;
  const float* wa = p.in[17] + (size_t)l * 4 * 128 * 128;
  const float* ba = p.in[18] + (size_t)l * 512;
  const float* wx = p.in[19] + (size_t)l * 4 * 128 * 128;
  const float* bx = p.in[20] + (size_t)l * 512;
  const float* lam = p.in[21] + (size_t)l * 512;
  const float* w2 = p.in[22] + (size_t)l * 16 * 256;
  const float* b2 = p.in[23] + (size_t)l * 256;
  const float* a_log = p.in[12] + l * 4;
  const float* dt_bias = p.in[13] + l * 4;

  for (int tt = blockIdx.x; tt < MROWS / 16; tt += gridDim.x) {
    const int r0 = tt * 16;
    const bool pr = r0 < NPR;
    const int t0 = pr ? (r0 % LP) : 0;
    const int s0 = r0 - NPR;
    if (tid < 64) {
      const int i = tid >> 2, hh = tid & 3;
      const float* pr_ = proj + (size_t)(r0 + i) * LDP;
      const float g = -expf(a_log[hh]) * softplusf_(pr_[C_ALPHA + hh] + dt_bias[hh]);
      prep[(size_t)(r0 + i) * PREP_LD + P_AB + hh] = expf(g);
      prep[(size_t)(r0 + i) * PREP_LD + P_AB + 4 + hh] = sigmoidf_(pr_[C_BETA + hh]);
    }
    {
      const int c = tid;
      const float w0 = conv_b[0 * 512 + c], w1 = conv_b[1 * 512 + c], w2_ = conv_b[2 * 512 + c], w3 = conv_b[3 * 512 + c];
      const float bias = cbb[c];
      if (pr) {
        float xw[19];
#pragma unroll
        for (int q = 0; q < 19; ++q) {
          const int t = t0 - 3 + q;
          xw[q] = 0.f;
          if (t >= 0) xw[q] = proj[(size_t)(r0 - 3 + q) * LDP + C_XB + c];
        }
#pragma unroll
        for (int i = 0; i < 16; ++i) { const float xv_ = bias + w3 * xw[i + 3] + w2_ * xw[i + 2] + w1 * xw[i + 1] + w0 * xw[i]; xs_t[c * 20 + i] = xv_; xs16[i * 520 + c] = f2bf(xv_); }
      } else {
#pragma unroll
        for (int bq = 0; bq < 4; ++bq) {
          const int bb = (s0 >> 2) + bq;
          float xw[7];
#pragma unroll
          for (int q = 0; q < 3; ++q) xw[q] = cst_b[((size_t)bb * 3 + q) * 512 + c];
#pragma unroll
          for (int q = 0; q < 4; ++q) xw[3 + q] = proj[(size_t)(r0 + bq * 4 + q) * LDP + C_XB + c];
#pragma unroll
          for (int q = 0; q < 4; ++q) { const float xv_ = bias + w3 * xw[q + 3] + w2_ * xw[q + 2] + w1 * xw[q + 1] + w0 * xw[q]; xs_t[c * 20 + bq * 4 + q] = xv_; xs16[(bq * 4 + q) * 520 + c] = f2bf(xv_); }
        }
      }
    }
    __syncthreads();
    {
      const int blk = w >> 1, g = w & 1;
      const unsigned short* wg = wtg + ((size_t)((l * 4 + blk) * 2 + g) * 128) * 128;
      const int mrow = lane & 15, q = lane >> 4;
      bf16x8 afr[4];
#pragma unroll
      for (int ks = 0; ks < 4; ++ks) afr[ks] = *(const bf16x8*)(xs16 + mrow * 520 + blk * 128 + ks * 32 + q * 8);
      f32x4 acc[8];
#pragma unroll
      for (int nt = 0; nt < 8; ++nt) {
        acc[nt] = (f32x4){0.f, 0.f, 0.f, 0.f};
#pragma unroll
        for (int ks = 0; ks < 4; ++ks) {
          const bf16x8 bfr = *(const bf16x8*)(wg + (size_t)(nt * 16 + mrow) * 128 + ks * 32 + q * 8);
          acc[nt] = __builtin_amdgcn_mfma_f32_16x16x32_bf16(afr[ks], bfr, acc[nt], 0, 0, 0);
        }
      }
#pragma unroll
      for (int nt = 0; nt < 8; ++nt)
#pragma unroll
        for (int jj = 0; jj < 4; ++jj) gl[(g * 16 + q * 4 + jj) * 512 + blk * 128 + nt * 16 + mrow] = acc[nt][jj];
    }
    __syncthreads();
    {
      const int ch = tid;
      const float bav = ba[ch], bxv = bx[ch];
      const float sp = softplusf_(-lam[ch]);
#pragma unroll
      for (int i = 0; i < 16; ++i) {
        const float xb = xs_t[ch * 20 + i];
        const float rg = sigmoidf_(gl[i * 512 + ch] + bav), ig = sigmoidf_(gl[(16 + i) * 512 + ch] + bxv);
        const float log_a = -8.f * rg * sp;
        const float a = __expf(log_a);
        const float x2 = 2.f * log_a;
        const float om = x2 > -0.02f ? -x2 * (1.f + x2 * (0.5f + x2 * (1.f / 6.f))) : 1.f - a * a;
        const float bc = sqrtf(om) * (ig * xb);
        prep[(size_t)(r0 + i) * PREP_LD + P_LA + ch] = a;
        prep[(size_t)(r0 + i) * PREP_LD + P_LB + ch] = bc;
      }
    }
    __syncthreads();
  }
  {
    const int gw = blockIdx.x * 8 + wv, GW = gridDim.x * 8;
#pragma unroll 1
    for (int it = gw; it < (MROWS / 16) * 44; it += GW) {
      const int tt = it / 44, sub = it % 44;
      const int r0 = tt * 16;
      const bool pr = r0 < NPR;
      const int t0 = pr ? (r0 % LP) : 0;
      const int s0 = r0 - NPR;
    if (sub < 24) {
      const int vec = sub % 12, hf = sub / 12, ib = hf * 8;
      const int cc = vec * 128 + lane * 2;
      const float2 wv0 = *(const float2*)(conv_a + 0 * 1536 + cc), wv1 = *(const float2*)(conv_a + 1 * 1536 + cc);
      const float2 wv2 = *(const float2*)(conv_a + 2 * 1536 + cc), wv3 = *(const float2*)(conv_a + 3 * 1536 + cc);
#define CONV_OUT(i_, x0, x1, x2, x3) do { \
        float y0 = wv3.x * (x0).x + wv2.x * (x1).x + wv1.x * (x2).x + wv0.x * (x3).x; \
        float y1 = wv3.y * (x0).y + wv2.y * (x1).y + wv1.y * (x2).y + wv0.y * (x3).y; \
        y0 = siluf_(y0); y1 = siluf_(y1); \
        if (vec < 8) { const float ss = wave_allsum(y0 * y0 + y1 * y1); float sc = rsqrtf(ss + 1e-6f); \
          if (vec < 4) sc *= 0.08838834764831845f; y0 *= sc; y1 *= sc; } \
        *(float2*)(prep + (size_t)(r0 + (i_)) * PREP_LD + cc) = make_float2(y0, y1); } while (0)
      if (pr) {
        float2 xw[11];
#pragma unroll
        for (int q = 0; q < 11; ++q) {
          const int t = t0 + ib - 3 + q;
          const float* ptr = proj + (size_t)(r0 + ib - 3 + q) * LDP + cc;
          xw[q] = (t >= 0) ? *(const float2*)ptr : make_float2(0.f, 0.f);
        }
#pragma unroll
        for (int ii = 0; ii < 8; ++ii) CONV_OUT(ib + ii, xw[ii + 3], xw[ii + 2], xw[ii + 1], xw[ii]);
      } else {
#pragma unroll 2
        for (int ii = 0; ii < 8; ++ii) {
          const int i = ib + ii;
          const int tl = (s0 + i) & 3, bb = (s0 + i) >> 2;
          const float* cs = cst_a + (size_t)bb * 3 * 1536 + cc;
          const float* pj = proj + (size_t)(r0 + i) * LDP + cc;
          const float2 x0 = *(const float2*)pj;
          const float2 x1 = tl >= 1 ? *(const float2*)(pj - LDP) : *(const float2*)(cs + (2 + tl) * 1536);
          const float2 x2 = tl >= 2 ? *(const float2*)(pj - 2 * LDP) : *(const float2*)(cs + (1 + tl) * 1536);
          const float2 x3 = tl >= 3 ? *(const float2*)(pj - 3 * LDP) : *(const float2*)(cs + (0 + tl) * 1536);
          CONV_OUT(i, x0, x1, x2, x3);
        }
      }
#undef CONV_OUT
    }
    else if (sub < 28) {
      const int cq = sub - 24, ch = cq * 64 + lane;
      float rcv[4];
#pragma unroll
      for (int m = 0; m < 4; ++m) rcv[m] = proj[(size_t)(r0 + (lane >> 4) + 4 * m) * LDP + C_RC + (lane & 15)];
      float w2v[16];
#pragma unroll
      for (int jj = 0; jj < 16; ++jj) w2v[jj] = w2[jj * 256 + ch];
      const float b2v = b2[ch];
      float qv[16], kv[16];
#pragma unroll
      for (int i = 0; i < 16; ++i) { qv[i] = proj[(size_t)(r0 + i) * LDP + C_QC + ch]; kv[i] = proj[(size_t)(r0 + i) * LDP + C_KC + ch]; }
      float P = 1.f;
#pragma unroll
      for (int i = 0; i < 16; ++i) {
        float z = b2v;
#pragma unroll
        for (int jj = 0; jj < 16; ++jj)
          z += __builtin_bit_cast(float, __builtin_amdgcn_readlane(__builtin_bit_cast(int, rcv[i >> 2]), (i & 3) * 16 + jj)) * w2v[jj];
        const float al = __expf(-softplusf_(-z) * (1.f / 16.f));
        float* pp = prep + (size_t)(r0 + i) * PREP_LD;
        if (pr) { P *= al; pp[P_QC + ch] = qv[i] * 0.125f * P; pp[P_KC + ch] = kv[i] / P; }
        else { pp[P_QC + ch] = qv[i] * 0.125f; pp[P_KC + ch] = kv[i]; pp[P_AC + ch] = al; }
      }
      if (pr) ((float*)(p.ws + WS_GDEC))[(size_t)tt * 256 + ch] = P;
    } else {
      const int i = sub - 28;
      const int pos = pr ? (t0 + i) : (16384 + ((s0 + i) & 3));
      const float* pr_ = proj + (size_t)(r0 + i) * LDP;
      float* pp = prep + (size_t)(r0 + i) * PREP_LD;
      const int f = lane & 31, hb = lane >> 5;
      const float freq = exp2f(-(float)f * (13.287712379549449f / 32.f));
      const float ang = (float)pos * freq;
      double rev = (double)ang * 0.15915494309189535;
      rev -= floor(rev);
      const float fr_ = (float)rev;
      const float cs = __builtin_amdgcn_cosf(fr_), sn = __builtin_amdgcn_sinf(fr_);
#pragma unroll
      for (int m = 0; m < 2; ++m) {
        const int hh = hb + 2 * m;
        float gq = 1.f, gk = 0.125f;
        if (pr) { const float lgam = log2f(1.f - exp2f(-5.f - (float)hh)); gq = exp2f((float)(i + 1) * lgam); gk = 0.125f * exp2f(-(float)(i + 1) * lgam); }
        const float q1 = pr_[C_QD + hh * 64 + f] * gq, q2 = pr_[C_QD + hh * 64 + 32 + f] * gq;
        const float k1 = pr_[C_KD + hh * 64 + f] * gk, k2 = pr_[C_KD + hh * 64 + 32 + f] * gk;
        pp[P_QD + hh * 64 + f] = q1 * cs - q2 * sn;
        pp[P_QD + hh * 64 + 32 + f] = q2 * cs + q1 * sn;
        pp[P_KD + hh * 64 + f] = k1 * cs - k2 * sn;
        pp[P_KD + hh * 64 + 32 + f] = k2 * cs + k1 * sn;
      }
    }
    }
  }
  const size_t gtid = (size_t)blockIdx.x * NTHR + tid, gsz = (size_t)gridDim.x * NTHR;
  for (size_t idx = gtid; idx < (size_t)132 * 3 * 2048; idx += gsz) {
    const int c = (int)(idx & 2047), jj = (int)((idx >> 11) % 3), bb = (int)(idx / (2048 * 3));
    const size_t row = bb < 4 ? (size_t)(bb * LP + LP - 3 + jj) : (size_t)(NPR + (bb - 4) * 4 + 1 + jj);
    if (c < 1536) {
      const float v = proj[row * LDP + c];
      if (bb < 4) p.out[O_PDC + ((size_t)(l * 4 + bb) * 3 + jj) * 1536 + c] = v;
      else p.out[O_SDC + ((size_t)(l * 128 + bb - 4) * 3 + jj) * 1536 + c] = v;
    } else {
      const int c2 = c - 1536;
      const float v = proj[row * LDP + C_XB + c2];
      if (bb < 4) p.out[O_PLC + ((size_t)(l * 4 + bb) * 3 + jj) * 512 + c2] = v;
      else p.out[O_SLC + ((size_t)(l * 128 + bb - 4) * 3 + jj) * 512 + c2] = v;
    }
  }
}

using f2 = __attribute__((ext_vector_type(2))) float;
constexpr int NST = LP / 16;

template <int MODE>
__device__ __forceinline__ void scan_prompt_half(CP& p, int l, int bh, int cg, float* sm, int rt) {
  constexpr int DK = MODE == 0 ? 128 : 64;
  constexpr int EPL = DK / 16, E2 = EPL / 2;
  constexpr int QOFF = MODE == 0 ? P_QA : (MODE == 1 ? P_QC : P_QD);
  constexpr int KOFF = MODE == 0 ? P_KA : (MODE == 1 ? P_KC : P_KD);
  constexpr int OB = MODE == 0 ? 0 : (MODE == 1 ? 1024 : 1536);
  constexpr int BUFSZ = 48 * DK + 256 + 32;
  const int lane = rt & 63, wl = rt >> 6;
  const int b = bh >> 2, h = bh & 3;
  const int j = lane & 15, cl = wl * 4 + (lane >> 4);
  const float* prep = (const float*)(p.ws + WS_PREP) + (size_t)(b * LP) * PREP_LD;
  const float* proj = (const float*)(p.ws + WS_PROJ) + (size_t)(b * LP) * LDP;
  float* obuf = (float*)(p.ws + WS_OBUF) + (size_t)(b * LP) * 2048;
  f2 s[E2];
#pragma unroll
  for (int e = 0; e < E2; ++e) s[e] = (f2){0.f, 0.f};
  const float gamma = 1.f - exp2f(-5.f - (float)h);
  const int lt0 = rt / (DK / 4), lc0 = (rt % (DK / 4)) * 4;
  const int lt1 = (rt + 256) / (DK / 4);
  const bool ld_v = rt < 64;
  const int vt = rt >> 2, vc = (rt & 3) * 4;
  float4 rq0_0 = make_float4(0, 0, 0, 0), rq1_0 = rq0_0, rk0_0 = rq0_0, rk1_0 = rq0_0, ral_0 = rq0_0, rv_0 = rq0_0; float rsc_0 = 0.f;
  float4 rq0_1 = rq0_0, rq1_1 = rq0_0, rk0_1 = rq0_0, rk1_1 = rq0_0, ral_1 = rq0_0, rv_1 = rq0_0; float rsc_1 = 0.f;
#define GLOAD(st_, S) do { const int t0_ = (st_) * 16; \
    { const float* rp_ = prep + (size_t)(t0_ + lt0) * PREP_LD; rq0_##S = *(const float4*)(rp_ + QOFF + h * DK + lc0); \
      rk0_##S = *(const float4*)(rp_ + KOFF + h * DK + lc0); if (MODE == 1) ral_##S = *(const float4*)(rp_ + P_AC + h * 64 + lc0); } \
    if (MODE == 0) { const float* rp_ = prep + (size_t)(t0_ + lt1) * PREP_LD; rq1_##S = *(const float4*)(rp_ + QOFF + h * DK + lc0); \
      rk1_##S = *(const float4*)(rp_ + KOFF + h * DK + lc0); } \
    if (ld_v) { if (MODE == 0) rv_##S = *(const float4*)(prep + (size_t)(t0_ + vt) * PREP_LD + P_VA + h * 128 + cg * 16 + vc); \
      else rv_##S = *(const float4*)(proj + (size_t)(t0_ + vt) * LDP + (MODE == 1 ? C_VC : C_VD) + h * 128 + cg * 16 + vc); } \
    if (MODE == 0 && rt < 32) rsc_##S = prep[(size_t)(t0_ + (rt & 15)) * PREP_LD + (rt < 16 ? P_AB : P_AB + 4) + h]; } while (0)
#define LSTORE(bf_, S) do { *(float4*)((bf_) + lt0 * DK + lc0) = rq0_##S; *(float4*)((bf_) + 16 * DK + lt0 * DK + lc0) = rk0_##S; \
    if (MODE == 1) *(float4*)((bf_) + 32 * DK + lt0 * DK + lc0) = ral_##S; \
    if (MODE == 0) { *(float4*)((bf_) + lt1 * DK + lc0) = rq1_##S; *(float4*)((bf_) + 16 * DK + lt1 * DK + lc0) = rk1_##S; } \
    if (ld_v) *(float4*)((bf_) + 48 * DK + vt * 16 + vc) = rv_##S; \
    if (MODE == 0 && rt < 32) (bf_)[48 * DK + 256 + rt] = rsc_##S; } while (0)
  GLOAD(0, 0);
  LSTORE(sm, 0);
  GLOAD(1, 1);
  __syncthreads();
  auto stage = [&](const int st, const int SL) __attribute__((always_inline)) {
    const float* bf = sm + (st & 1) * BUFSZ;
    float* bn = sm + ((st + 1) & 1) * BUFSZ;
    if (st + 2 < NST) { if (SL == 0) GLOAD(st + 2, 0); else GLOAD(st + 2, 1); }
    float okeep = 0.f;
    f2 kkb[3][E2], qqb[3][E2]; float vvb[3], aab[3], beb[3]; float4 alb[3];
#define LOADTOK(ti_, S_) do { \
      _Pragma("unroll") for (int e4 = 0; e4 < EPL / 4; ++e4) { \
        const float4 k4 = *(const float4*)(bf + 16 * DK + (ti_) * DK + j * EPL + e4 * 4); \
        const float4 q4 = *(const float4*)(bf + (ti_) * DK + j * EPL + e4 * 4); \
        kkb[S_][e4 * 2 + 0] = (f2){k4.x, k4.y}; kkb[S_][e4 * 2 + 1] = (f2){k4.z, k4.w}; \
        qqb[S_][e4 * 2 + 0] = (f2){q4.x, q4.y}; qqb[S_][e4 * 2 + 1] = (f2){q4.z, q4.w}; } \
      vvb[S_] = bf[48 * DK + (ti_) * 16 + cl]; \
      if (MODE == 0) { aab[S_] = bf[48 * DK + 256 + (ti_)]; beb[S_] = bf[48 * DK + 256 + 16 + (ti_)]; } \
      if (MODE == 1) alb[S_] = *(const float4*)(bf + 32 * DK + (ti_) * DK + j * EPL); } while (0)
    LOADTOK(0, 0);
    LOADTOK(1, 1);
#pragma unroll
    for (int ti = 0; ti < 16; ++ti) {
      constexpr int dummy_ = 0; (void)dummy_;
      const int cs = ti % 3;
      if (ti + 2 < 16) { LOADTOK(ti + 2, (ti + 2) % 3); }
      __builtin_amdgcn_sched_barrier(0);
      f2 kk[E2], qq[E2];
#pragma unroll
      for (int e = 0; e < E2; ++e) { kk[e] = kkb[cs][e]; qq[e] = qqb[cs][e]; }
      const float vv = vvb[cs];
      if (MODE == 0) {
        f2 ra = kk[0] * s[0];
#pragma unroll
        for (int e = 1; e < E2; ++e) ra = kk[e] * s[e] + ra;
        const float r = row16_allsum(ra.x + ra.y);
        const float a = aab[cs], be = beb[cs];
        const float dd = be * (vv - a * r);
        const f2 a2 = (f2){a, a}, d2 = (f2){dd, dd};
#pragma unroll
        for (int e = 0; e < E2; ++e) s[e] = kk[e] * d2 + a2 * s[e];
      } else if (MODE == 1) {
        const float4 a4 = alb[cs];
        const f2 v2 = (f2){vv, vv};
        s[0] = kk[0] * v2 + ((f2){a4.x, a4.y}) * s[0];
        s[1] = kk[1] * v2 + ((f2){a4.z, a4.w}) * s[1];
      } else {
        const f2 v2 = (f2){vv, vv}, g2 = (f2){gamma, gamma};
#pragma unroll
        for (int e = 0; e < E2; ++e) s[e] = kk[e] * v2 + g2 * s[e];
      }
      f2 oa = qq[0] * s[0];
#pragma unroll
      for (int e = 1; e < E2; ++e) oa = qq[e] * s[e] + oa;
      const float o = row16_allsum(oa.x + oa.y);
      if (j == ti) okeep = o;
    }
#undef LOADTOK
    if (st + 1 < NST) { if (SL == 0) LSTORE(bn, 1); else LSTORE(bn, 0); }
    obuf[(size_t)(st * 16 + j) * 2048 + OB + h * 128 + cg * 16 + cl] = okeep;
    __syncthreads();
    };
#pragma unroll 1
  for (int st = 0; st + 1 < NST; st += 2) { stage(st, 0); stage(st + 1, 1); }
  stage(NST - 1, 0);
#undef GLOAD
#undef LSTORE
  float* so = p.out + (MODE == 0 ? O_PD : (MODE == 1 ? O_PG : O_PR)) + ((size_t)(l * 4 + b) * 4 + h) * DK * 128;
#pragma unroll
  for (int e = 0; e < E2; ++e) {
    so[(size_t)(j * EPL + 2 * e) * 128 + cg * 16 + cl] = s[e].x;
    so[(size_t)(j * EPL + 2 * e + 1) * 128 + cg * 16 + cl] = s[e].y;
  }
}

__device__ __forceinline__ void phase_prep2(CP& p, int wv) {
  extern __shared__ __attribute__((aligned(16))) unsigned char smem_raw[];
  const int tid = opaque_tid(wv), hd = tid >> 7, d = tid & 127;
  float* hs = (float*)smem_raw + hd * 4864;
  float* kS = hs; float* vS = hs + 2112; float* AS = hs + 4224; float* TS = hs + 4496; float* lgS = hs + 4768; float* gcS = hs + 4784; float* beS = hs + 4800;
  float* prep = (float*)(p.ws + WS_PREP);
#pragma unroll 1
  for (int tile = blockIdx.x; tile < 4 * NST; tile += gridDim.x) {
    const int r0 = tile * 16;
#pragma unroll
    for (int i = 0; i < 16; ++i) {
      kS[i * 132 + d] = prep[(size_t)(r0 + i) * PREP_LD + P_KA + hd * 128 + d];
      vS[i * 132 + d] = prep[(size_t)(r0 + i) * PREP_LD + P_VA + hd * 128 + d];
    }
    if (d < 16) { lgS[d] = logf(prep[(size_t)(r0 + d) * PREP_LD + P_AB + hd]); beS[d] = prep[(size_t)(r0 + d) * PREP_LD + P_AB + 4 + hd]; }
    __syncthreads();
    if (d < 16) { float g = 0.f; for (int m = 0; m <= d; ++m) g += lgS[m]; gcS[d] = g; }
    float dots[2];
#pragma unroll
    for (int e2 = 0; e2 < 2; ++e2) {
      const int e = d + 128 * e2, i = e >> 4, m = e & 15;
      float acc = 0.f;
      if (m < i) {
        const float4* ki = (const float4*)(kS + i * 132); const float4* km = (const float4*)(kS + m * 132);
#pragma unroll 8
        for (int c = 0; c < 32; ++c) { const float4 x = ki[c], y = km[c]; acc += x.x * y.x + x.y * y.y + x.z * y.z + x.w * y.w; }
      }
      dots[e2] = acc;
    }
    __syncthreads();
#pragma unroll
    for (int e2 = 0; e2 < 2; ++e2) {
      const int e = d + 128 * e2, i = e >> 4, m = e & 15;
      AS[i * 17 + m] = (m < i) ? beS[i] * dots[e2] * __expf(gcS[i] - gcS[m]) : 0.f;
    }
    __syncthreads();
    if (d < 16) {
      float tcol[16];
#pragma unroll
      for (int i = 0; i < 16; ++i) {
        float t = (i == d) ? 1.f : 0.f;
#pragma unroll
        for (int m = 0; m < i; ++m) t -= AS[i * 17 + m] * tcol[m];
        tcol[i] = t;
      }
#pragma unroll
      for (int i = 0; i < 16; ++i) TS[i * 17 + d] = tcol[i];
    }
    __syncthreads();
    {
      float xk[16], xv[16];
#pragma unroll
      for (int m = 0; m < 16; ++m) { const float bm = beS[m]; xk[m] = bm * __expf(gcS[m]) * kS[m * 132 + d]; xv[m] = bm * vS[m * 132 + d]; }
      const float g15 = gcS[15];
#pragma unroll
      for (int i = 0; i < 16; ++i) {
        float W = 0.f, U = 0.f;
#pragma unroll
        for (int m = 0; m <= i; ++m) { const float t = TS[i * 17 + m]; W += t * xk[m]; U += t * xv[m]; }
        float* pp = prep + (size_t)(r0 + i) * PREP_LD;
        pp[P_WA + hd * 128 + d] = W;
        pp[P_VA + hd * 128 + d] = U;
        pp[P_KH + hd * 128 + d] = kS[i * 132 + d] * __expf(g15 - gcS[i]);
      }
      if (d < 16) prep[(size_t)(r0 + d) * PREP_LD + P_GC + hd] = __expf(gcS[d]);
#pragma unroll
      for (int e2 = 0; e2 < 2; ++e2) {
        const int e = d + 128 * e2, i = e >> 4, m = e & 15;
        prep[(size_t)(r0 + i) * PREP_LD + P_DM + hd * 16 + m] = (m <= i) ? __expf(gcS[i] - gcS[m]) : 0.f;
      }
    }
    __syncthreads();
  }
}

__device__ __forceinline__ void scan_prompt_delta_mfma(CP& p, int l, int bh, int half, float* sm, int rt) {
  constexpr int BUFSZ = 10464;
  const int lane = rt & 63, wl = rt >> 6, n = lane & 15, q = lane >> 4;
  const int b = bh >> 2, h = bh & 3;
  const int col0 = half * 64 + wl * 16;
  const float* prep = (const float*)(p.ws + WS_PREP) + (size_t)(b * LP) * PREP_LD;
  float* obuf = (float*)(p.ws + WS_OBUF) + (size_t)(b * LP) * 2048 + h * 128 + col0 + n;
  f32x4 St[8];
#pragma unroll
  for (int kt = 0; kt < 8; ++kt) St[kt] = (f32x4){0.f, 0.f, 0.f, 0.f};
  const int lt0 = rt >> 5, lt1 = lt0 + 8, lc = (rt & 31) * 4;
  const int tt_ = rt & 15, tc = (rt >> 4) * 4;
  float4 rq0_0, rq1_0, rk0_0, rk1_0, rw0_0, rw1_0, rh0_0, rh1_0, ru_0, rd_0 = make_float4(0, 0, 0, 0); float rg_0 = 0.f;
  float4 rq0_1, rq1_1, rk0_1, rk1_1, rw0_1, rw1_1, rh0_1, rh1_1, ru_1, rd_1 = make_float4(0, 0, 0, 0); float rg_1 = 0.f;
  rq0_0 = rq1_0 = rk0_0 = rk1_0 = rw0_0 = rw1_0 = rh0_0 = rh1_0 = ru_0 = make_float4(0, 0, 0, 0);
  rq0_1 = rq1_1 = rk0_1 = rk1_1 = rw0_1 = rw1_1 = rh0_1 = rh1_1 = ru_1 = make_float4(0, 0, 0, 0);
#define GLOADD(st_, S) do { const float* ra_ = prep + (size_t)((st_) * 16 + lt0) * PREP_LD + h * 128 + lc; \
    const float* rb_ = prep + (size_t)((st_) * 16 + lt1) * PREP_LD + h * 128 + lc; \
    rq0_##S = *(const float4*)(ra_ + P_QA); rq1_##S = *(const float4*)(rb_ + P_QA); rk0_##S = *(const float4*)(ra_ + P_KA); rk1_##S = *(const float4*)(rb_ + P_KA); \
    rw0_##S = *(const float4*)(ra_ + P_WA); rw1_##S = *(const float4*)(rb_ + P_WA); \
    const float* rt__ = prep + (size_t)((st_) * 16 + tt_) * PREP_LD + h * 128; \
    rh0_##S = *(const float4*)(rt__ + P_KH + tc); rh1_##S = *(const float4*)(rt__ + P_KH + 64 + tc); \
    ru_##S = *(const float4*)(rt__ + P_VA + half * 64 + tc); \
    if (rt < 16) rg_##S = prep[(size_t)((st_) * 16 + rt) * PREP_LD + P_GC + h]; \
    if (rt < 64) rd_##S = *(const float4*)(prep + (size_t)((st_) * 16 + (rt >> 2)) * PREP_LD + P_DM + h * 16 + (rt & 3) * 4); } while (0)
#define LSTORED(bf_, S) do { *(float4*)((bf_) + lt0 * 132 + lc) = rq0_##S; *(float4*)((bf_) + lt1 * 132 + lc) = rq1_##S; \
    *(float4*)((bf_) + 2112 + lt0 * 132 + lc) = rk0_##S; *(float4*)((bf_) + 2112 + lt1 * 132 + lc) = rk1_##S; \
    *(float4*)((bf_) + 4224 + lt0 * 132 + lc) = rw0_##S; *(float4*)((bf_) + 4224 + lt1 * 132 + lc) = rw1_##S; \
    (bf_)[6336 + (tc + 0) * 20 + tt_] = rh0_##S.x; (bf_)[6336 + (tc + 1) * 20 + tt_] = rh0_##S.y; (bf_)[6336 + (tc + 2) * 20 + tt_] = rh0_##S.z; (bf_)[6336 + (tc + 3) * 20 + tt_] = rh0_##S.w; \
    (bf_)[6336 + (tc + 64) * 20 + tt_] = rh1_##S.x; (bf_)[6336 + (tc + 65) * 20 + tt_] = rh1_##S.y; (bf_)[6336 + (tc + 66) * 20 + tt_] = rh1_##S.z; (bf_)[6336 + (tc + 67) * 20 + tt_] = rh1_##S.w; \
    (bf_)[8896 + (tc + 0) * 20 + tt_] = ru_##S.x; (bf_)[8896 + (tc + 1) * 20 + tt_] = ru_##S.y; (bf_)[8896 + (tc + 2) * 20 + tt_] = ru_##S.z; (bf_)[8896 + (tc + 3) * 20 + tt_] = ru_##S.w; \
    if (rt < 16) (bf_)[10176 + rt] = rg_##S; \
    if (rt < 64) *(float4*)((bf_) + 10208 + rt * 4) = rd_##S; } while (0)
  GLOADD(0, 0);
  LSTORED(sm, 0);
  GLOADD(1, 1);
  __syncthreads();
  auto stage = [&](const int st, const int SL) __attribute__((always_inline)) {
    const float* bf = sm + (st & 1) * BUFSZ;
    float* bn = sm + ((st + 1) & 1) * BUFSZ;
    if (st + 2 < NST) { if (SL == 0) GLOADD(st + 2, 0); else GLOADD(st + 2, 1); }
    const float4 egm = *(const float4*)(bf + 10176 + 4 * q);
    const float4 dm4 = *(const float4*)(bf + 10208 + n * 16 + 4 * q);
    const float e15 = bf[10176 + 15];
    f32x4 ws = (f32x4){0.f, 0.f, 0.f, 0.f}, qs = ws, pt = ws;
#pragma unroll
    for (int ks = 0; ks < 4; ++ks) {
      const int o0 = n * 132 + 32 * ks + 4 * q;
      const float4 qa = *(const float4*)(bf + o0), qb = *(const float4*)(bf + o0 + 16);
      const float4 ka = *(const float4*)(bf + 2112 + o0), kb = *(const float4*)(bf + 2112 + o0 + 16);
      const float4 wa = *(const float4*)(bf + 4224 + o0), wb = *(const float4*)(bf + 4224 + o0 + 16);
      const bf16x8 QF = mkfrag(cvtpk(qa.x, qa.y), cvtpk(qa.z, qa.w), cvtpk(qb.x, qb.y), cvtpk(qb.z, qb.w));
      const bf16x8 KF = mkfrag(cvtpk(ka.x, ka.y), cvtpk(ka.z, ka.w), cvtpk(kb.x, kb.y), cvtpk(kb.z, kb.w));
      const bf16x8 WF = mkfrag(cvtpk(wa.x, wa.y), cvtpk(wa.z, wa.w), cvtpk(wb.x, wb.y), cvtpk(wb.z, wb.w));
      const bf16x8 SB = mkfrag(cvtpk(St[2 * ks][0], St[2 * ks][1]), cvtpk(St[2 * ks][2], St[2 * ks][3]),
                               cvtpk(St[2 * ks + 1][0], St[2 * ks + 1][1]), cvtpk(St[2 * ks + 1][2], St[2 * ks + 1][3]));
      ws = __builtin_amdgcn_mfma_f32_16x16x32_bf16(WF, SB, ws, 0, 0, 0);
      qs = __builtin_amdgcn_mfma_f32_16x16x32_bf16(QF, SB, qs, 0, 0, 0);
      pt = __builtin_amdgcn_mfma_f32_16x16x32_bf16(KF, QF, pt, 0, 0, 0);
    }
    const float4 u4 = *(const float4*)(bf + 8896 + (wl * 16 + n) * 20 + 4 * q);
    const float vn0 = u4.x - ws[0], vn1 = u4.y - ws[1], vn2 = u4.z - ws[2], vn3 = u4.w - ws[3];
    const bf16x8 VNF = mkfrag(cvtpk(vn0, vn1), cvtpk(vn2, vn3), 0u, 0u);
    const float p0 = pt[0] * dm4.x, p1 = pt[1] * dm4.y, p2 = pt[2] * dm4.z, p3 = pt[3] * dm4.w;
    const bf16x8 PF = mkfrag(cvtpk(p0, p1), cvtpk(p2, p3), 0u, 0u);
    f32x4 qsc;
    qsc[0] = qs[0] * egm.x; qsc[1] = qs[1] * egm.y; qsc[2] = qs[2] * egm.z; qsc[3] = qs[3] * egm.w;
    const f32x4 o = __builtin_amdgcn_mfma_f32_16x16x32_bf16(PF, VNF, qsc, 0, 0, 0);
#pragma unroll
    for (int r = 0; r < 4; ++r) obuf[(size_t)(st * 16 + 4 * q + r) * 2048] = o[r];
#pragma unroll
    for (int kt = 0; kt < 8; ++kt) {
      const float4 k4 = *(const float4*)(bf + 6336 + (16 * kt + n) * 20 + 4 * q);
      const bf16x8 KTF = mkfrag(cvtpk(k4.x, k4.y), cvtpk(k4.z, k4.w), 0u, 0u);
      f32x4 sc;
      sc[0] = St[kt][0] * e15; sc[1] = St[kt][1] * e15; sc[2] = St[kt][2] * e15; sc[3] = St[kt][3] * e15;
      St[kt] = __builtin_amdgcn_mfma_f32_16x16x32_bf16(KTF, VNF, sc, 0, 0, 0);
    }
    if (st + 1 < NST) { if (SL == 0) LSTORED(bn, 1); else LSTORED(bn, 0); }
    __syncthreads();
    };
#pragma unroll 1
  for (int st = 0; st + 1 < NST; st += 2) { stage(st, 0); stage(st + 1, 1); }
  stage(NST - 1, 0);
#undef GLOADD
#undef LSTORED
  float* so = p.out + O_PD + ((size_t)(l * 4 + b) * 4 + h) * 128 * 128 + col0 + n;
#pragma unroll
  for (int kt = 0; kt < 8; ++kt)
#pragma unroll
    for (int r = 0; r < 4; ++r) so[(size_t)(16 * kt + 4 * q + r) * 128] = St[kt][r];
}

template <int MODE>
__device__ __forceinline__ void scan_prompt_mfma(CP& p, int l, int bh, int half, float* sm, int rt) {
  constexpr int QOFF = MODE == 1 ? P_QC : P_QD, KOFF = MODE == 1 ? P_KC : P_KD, OB = MODE == 1 ? 1024 : 1536;
  constexpr int BUFSZ = 4800;
  const int lane = rt & 63, wl = rt >> 6, n = lane & 15, q = lane >> 4;
  const int b = bh >> 2, h = bh & 3;
  const int col0 = half * 64 + wl * 16;
  const float* prep = (const float*)(p.ws + WS_PREP) + (size_t)(b * LP) * PREP_LD + h * 64;
  const float* proj = (const float*)(p.ws + WS_PROJ) + (size_t)(b * LP) * LDP + (MODE == 1 ? C_VC : C_VD) + h * 128 + half * 64;
  float* obuf = (float*)(p.ws + WS_OBUF) + (size_t)(b * LP) * 2048 + OB + h * 128 + col0 + n;
  const float* gdec = (const float*)(p.ws + WS_GDEC) + (size_t)(b * NST) * 256 + h * 64;
  f32x4 St[4];
#pragma unroll
  for (int kt = 0; kt < 4; ++kt) St[kt] = (f32x4){0.f, 0.f, 0.f, 0.f};
  float g16 = 1.f - exp2f(-5.f - (float)h);
  g16 *= g16; g16 *= g16; g16 *= g16; g16 *= g16;
  const int lt = rt >> 4, lc = (rt & 15) * 4;
  const int tt_ = rt & 15, tc = (rt >> 4) * 4;
  float4 rq_0 = make_float4(0, 0, 0, 0), rk_0 = rq_0, rv_0 = rq_0, rp_0 = rq_0, rx_0 = rq_0, rq_1 = rq_0, rk_1 = rq_0, rv_1 = rq_0, rp_1 = rq_0, rx_1 = rq_0;
#define GLOADM(st_, S) do { const float* rp__ = prep + (size_t)((st_) * 16 + lt) * PREP_LD; \
    rq_##S = *(const float4*)(rp__ + QOFF + lc); rk_##S = *(const float4*)(rp__ + KOFF + lc); \
    rx_##S = *(const float4*)(prep + (size_t)((st_) * 16 + tt_) * PREP_LD + KOFF + tc); \
    rv_##S = *(const float4*)(proj + (size_t)((st_) * 16 + tt_) * LDP + tc); \
    if (MODE == 1 && rt < 16) rp_##S = *(const float4*)(gdec + (size_t)(st_) * 256 + rt * 4); } while (0)
#define LSTOREM(bf_, S) do { *(float4*)((bf_) + lt * 68 + lc) = rq_##S; *(float4*)((bf_) + 1088 + lt * 68 + lc) = rk_##S; \
    (bf_)[2176 + (tc + 0) * 20 + tt_] = rx_##S.x; (bf_)[2176 + (tc + 1) * 20 + tt_] = rx_##S.y; \
    (bf_)[2176 + (tc + 2) * 20 + tt_] = rx_##S.z; (bf_)[2176 + (tc + 3) * 20 + tt_] = rx_##S.w; \
    (bf_)[3456 + (tc + 0) * 20 + tt_] = rv_##S.x; (bf_)[3456 + (tc + 1) * 20 + tt_] = rv_##S.y; \
    (bf_)[3456 + (tc + 2) * 20 + tt_] = rv_##S.z; (bf_)[3456 + (tc + 3) * 20 + tt_] = rv_##S.w; \
    if (MODE == 1 && rt < 16) *(float4*)((bf_) + 4736 + rt * 4) = rp_##S; } while (0)
  GLOADM(0, 0);
  LSTOREM(sm, 0);
  GLOADM(1, 1);
  __syncthreads();
  auto stage = [&](const int st, const int SL) __attribute__((always_inline)) {
    const float* bf = sm + (st & 1) * BUFSZ;
    float* bn = sm + ((st + 1) & 1) * BUFSZ;
    if (st + 2 < NST) { if (SL == 0) GLOADM(st + 2, 0); else GLOADM(st + 2, 1); }
    bf16x8 QF[2], KF[2], SB[2];
#pragma unroll
    for (int ks = 0; ks < 2; ++ks) {
      const float4 qa = *(const float4*)(bf + n * 68 + 32 * ks + 4 * q), qb = *(const float4*)(bf + n * 68 + 32 * ks + 16 + 4 * q);
      const float4 ka = *(const float4*)(bf + 1088 + n * 68 + 32 * ks + 4 * q), kb = *(const float4*)(bf + 1088 + n * 68 + 32 * ks + 16 + 4 * q);
      QF[ks] = mkfrag(cvtpk(qa.x, qa.y), cvtpk(qa.z, qa.w), cvtpk(qb.x, qb.y), cvtpk(qb.z, qb.w));
      KF[ks] = mkfrag(cvtpk(ka.x, ka.y), cvtpk(ka.z, ka.w), cvtpk(kb.x, kb.y), cvtpk(kb.z, kb.w));
      SB[ks] = mkfrag(cvtpk(St[2 * ks][0], St[2 * ks][1]), cvtpk(St[2 * ks][2], St[2 * ks][3]),
                      cvtpk(St[2 * ks + 1][0], St[2 * ks + 1][1]), cvtpk(St[2 * ks + 1][2], St[2 * ks + 1][3]));
    }
    f32x4 qs = (f32x4){0.f, 0.f, 0.f, 0.f}, pt = qs;
    qs = __builtin_amdgcn_mfma_f32_16x16x32_bf16(QF[0], SB[0], qs, 0, 0, 0);
    qs = __builtin_amdgcn_mfma_f32_16x16x32_bf16(QF[1], SB[1], qs, 0, 0, 0);
    pt = __builtin_amdgcn_mfma_f32_16x16x32_bf16(KF[0], QF[0], pt, 0, 0, 0);
    pt = __builtin_amdgcn_mfma_f32_16x16x32_bf16(KF[1], QF[1], pt, 0, 0, 0);
#pragma unroll
    for (int r = 0; r < 4; ++r) if (4 * q + r > n) pt[r] = 0.f;
    const bf16x8 PF = mkfrag(cvtpk(pt[0], pt[1]), cvtpk(pt[2], pt[3]), 0u, 0u);
    const float4 v4 = *(const float4*)(bf + 3456 + (wl * 16 + n) * 20 + 4 * q);
    const bf16x8 VF = mkfrag(cvtpk(v4.x, v4.y), cvtpk(v4.z, v4.w), 0u, 0u);
    const f32x4 o = __builtin_amdgcn_mfma_f32_16x16x32_bf16(PF, VF, qs, 0, 0, 0);
#pragma unroll
    for (int r = 0; r < 4; ++r) obuf[(size_t)(st * 16 + 4 * q + r) * 2048] = o[r];
#pragma unroll
    for (int kt = 0; kt < 4; ++kt) {
      const float4 k4 = *(const float4*)(bf + 2176 + (16 * kt + n) * 20 + 4 * q);
      const bf16x8 KTF = mkfrag(cvtpk(k4.x, k4.y), cvtpk(k4.z, k4.w), 0u, 0u);
      St[kt] = __builtin_amdgcn_mfma_f32_16x16x32_bf16(KTF, VF, St[kt], 0, 0, 0);
      if (MODE == 1) {
        const float4 p4 = *(const float4*)(bf + 4736 + 16 * kt + 4 * q);
        St[kt][0] *= p4.x; St[kt][1] *= p4.y; St[kt][2] *= p4.z; St[kt][3] *= p4.w;
      } else {
        St[kt][0] *= g16; St[kt][1] *= g16; St[kt][2] *= g16; St[kt][3] *= g16;
      }
    }
    if (st + 1 < NST) { if (SL == 0) LSTOREM(bn, 1); else LSTOREM(bn, 0); }
    __syncthreads();
  };
#pragma unroll 1
  for (int st = 0; st + 1 < NST; st += 2) { stage(st, 0); stage(st + 1, 1); }
  stage(NST - 1, 0);
#undef GLOADM
#undef LSTOREM
  float* so = p.out + (MODE == 1 ? O_PG : O_PR) + ((size_t)(l * 4 + b) * 4 + h) * 64 * 128 + col0 + n;
#pragma unroll
  for (int kt = 0; kt < 4; ++kt)
#pragma unroll
    for (int r = 0; r < 4; ++r) so[(size_t)(16 * kt + 4 * q + r) * 128] = St[kt][r];
}

template <int MODE>
__device__ __forceinline__ void scan_sample(CP& p, int l, int item, int wv) {
  extern __shared__ __attribute__((aligned(16))) unsigned char smem_raw[];
  constexpr int DK = MODE == 0 ? 128 : 64;
  constexpr int NP = MODE == 0 ? 2 : 1;
  constexpr int RK = DK / NP;
  constexpr int E2 = RK / 2;
  constexpr int TPH = 128 * NP;
  constexpr int QOFF = MODE == 0 ? P_QA : (MODE == 1 ? P_QC : P_QD);
  constexpr int KOFF = MODE == 0 ? P_KA : (MODE == 1 ? P_KC : P_KD);
  constexpr int OB = MODE == 0 ? 0 : (MODE == 1 ? 1024 : 1536);
  const int tid = opaque_tid(wv);
  const int kp = NP == 2 ? (tid & 1) : 0;
  const int col = NP == 2 ? (tid >> 1) : tid;
  const int hl = col >> 7, v = col & 127;
  const int b = NP == 2 ? (item >> 1) : item;
  const int h = NP == 2 ? (item & 1) * 2 + hl : hl;
  const int ht = tid - hl * TPH;
  float* sm = (float*)smem_raw + hl * (12 * DK + 16);
  float* sq = sm; float* sk = sm + 4 * DK; float* sal = sm + 8 * DK; float* ssc = sm + 12 * DK;
  const size_t soff = ((size_t)(l * 128 + b) * 4 + h) * DK * 128 + (size_t)(kp * RK) * 128 + v;
  const float* st_in = (MODE == 0 ? p.in[2] : (MODE == 1 ? p.in[6] : p.in[7])) + soff;
  float* st_out = p.out + (MODE == 0 ? O_SD : (MODE == 1 ? O_SG : O_SR)) + soff;
  const float* prep = (const float*)(p.ws + WS_PREP) + (size_t)(NPR + b * 4) * PREP_LD;
  const float* proj = (const float*)(p.ws + WS_PROJ) + (size_t)(NPR + b * 4) * LDP;
  float* obuf = (float*)(p.ws + WS_OBUF) + (size_t)(NPR + b * 4) * 2048 + OB + h * 128 + v;
  f2 s[E2];
#pragma unroll
  for (int e = 0; e < E2; ++e) { s[e].x = st_in[(size_t)(2 * e) * 128]; s[e].y = st_in[(size_t)(2 * e + 1) * 128]; }
  for (int idx = ht; idx < 4 * DK; idx += TPH) {
    const int t = idx / DK, c = idx % DK;
    sq[idx] = prep[(size_t)t * PREP_LD + QOFF + h * DK + c];
    sk[idx] = prep[(size_t)t * PREP_LD + KOFF + h * DK + c];
    if (MODE == 1) sal[idx] = prep[(size_t)t * PREP_LD + P_AC + h * 64 + c];
  }
  if (MODE == 0 && ht < 8) ssc[ht] = prep[(size_t)(ht & 3) * PREP_LD + (ht < 4 ? P_AB : P_AB + 4) + h];
  float vv[4];
#pragma unroll
  for (int t = 0; t < 4; ++t)
    vv[t] = MODE == 0 ? prep[(size_t)t * PREP_LD + P_VA + h * 128 + v] : proj[(size_t)t * LDP + (MODE == 1 ? C_VC : C_VD) + h * 128 + v];
  const float gamma = 1.f - exp2f(-5.f - (float)h);
  __syncthreads();
#pragma unroll
  for (int t = 0; t < 4; ++t) {
    const float* kt = sk + t * DK + kp * RK; const float* qt = sq + t * DK + kp * RK;
    if (MODE == 0) {
      f2 ra0 = (f2){0.f, 0.f}, ra1 = ra0;
#pragma unroll
      for (int e = 0; e < E2; e += 2) {
        const float4 k4 = *(const float4*)(kt + 2 * e);
        ra0 = ((f2){k4.x, k4.y}) * s[e] + ra0; ra1 = ((f2){k4.z, k4.w}) * s[e + 1] + ra1;
      }
      float r = (ra0.x + ra0.y) + (ra1.x + ra1.y);
      r += dpp_f<0xB1>(r);
      const float a = ssc[t], be = ssc[4 + t];
      const float dd = be * (vv[t] - a * r);
      const f2 a2 = (f2){a, a}, d2 = (f2){dd, dd};
#pragma unroll
      for (int e = 0; e < E2; e += 2) {
        const float4 k4 = *(const float4*)(kt + 2 * e);
        s[e] = ((f2){k4.x, k4.y}) * d2 + a2 * s[e]; s[e + 1] = ((f2){k4.z, k4.w}) * d2 + a2 * s[e + 1];
      }
    } else if (MODE == 1) {
      const f2 v2 = (f2){vv[t], vv[t]};
#pragma unroll
      for (int e = 0; e < E2; e += 2) {
        const float4 k4 = *(const float4*)(kt + 2 * e);
        const float4 a4 = *(const float4*)(sal + t * DK + 2 * e);
        s[e] = ((f2){k4.x, k4.y}) * v2 + ((f2){a4.x, a4.y}) * s[e]; s[e + 1] = ((f2){k4.z, k4.w}) * v2 + ((f2){a4.z, a4.w}) * s[e + 1];
      }
    } else {
      const f2 v2 = (f2){vv[t], vv[t]}, g2 = (f2){gamma, gamma};
#pragma unroll
      for (int e = 0; e < E2; e += 2) {
        const float4 k4 = *(const float4*)(kt + 2 * e);
        s[e] = ((f2){k4.x, k4.y}) * v2 + g2 * s[e]; s[e + 1] = ((f2){k4.z, k4.w}) * v2 + g2 * s[e + 1];
      }
    }
    f2 oa0 = (f2){0.f, 0.f}, oa1 = oa0;
#pragma unroll
    for (int e = 0; e < E2; e += 2) {
      const float4 q4 = *(const float4*)(qt + 2 * e);
      oa0 = ((f2){q4.x, q4.y}) * s[e] + oa0; oa1 = ((f2){q4.z, q4.w}) * s[e + 1] + oa1;
    }
    float o = (oa0.x + oa0.y) + (oa1.x + oa1.y);
    if (NP == 2) o += dpp_f<0xB1>(o);
    if (kp == 0) obuf[(size_t)t * 2048] = o;
  }
#pragma unroll
  for (int e = 0; e < E2; ++e) { st_out[(size_t)(2 * e) * 128] = s[e].x; st_out[(size_t)(2 * e + 1) * 128] = s[e].y; }
  __syncthreads();
}

__device__ __forceinline__ void scan_lru_prompt(CP& p, int l, int b, int cgp, int wv) {
  extern __shared__ __attribute__((aligned(16))) unsigned char smem_raw[];
  float* sA = (float*)smem_raw; float* sB = sA + 512;
  const int tid = opaque_tid(wv);
  const int ch = tid & 31, seg = tid >> 5, c = cgp * 32 + ch;
  const float* prep = (const float*)(p.ws + WS_PREP) + (size_t)(b * LP + seg * 129) * PREP_LD + c;
  float* obuf = (float*)(p.ws + WS_OBUF) + (size_t)(b * LP + seg * 129) * 2048 + 512 + c;
  float A = 1.f, B = 0.f;
#pragma unroll 1
  for (int t0 = 0; t0 < 129; t0 += 43) {
    float av[43], bv[43];
#pragma unroll
    for (int i = 0; i < 43; ++i) { av[i] = prep[(size_t)(t0 + i) * PREP_LD + P_LA]; bv[i] = prep[(size_t)(t0 + i) * PREP_LD + P_LB]; }
#pragma unroll
    for (int i = 0; i < 43; ++i) { B = av[i] * B + bv[i]; A *= av[i]; }
  }
  sA[seg * 32 + ch] = A; sB[seg * 32 + ch] = B;
  __syncthreads();
  float h = 0.f;
  for (int s2 = 0; s2 < seg; ++s2) h = sA[s2 * 32 + ch] * h + sB[s2 * 32 + ch];
#pragma unroll 1
  for (int t0 = 0; t0 < 129; t0 += 43) {
    float av[43], bv[43];
#pragma unroll
    for (int i = 0; i < 43; ++i) { av[i] = prep[(size_t)(t0 + i) * PREP_LD + P_LA]; bv[i] = prep[(size_t)(t0 + i) * PREP_LD + P_LB]; }
#pragma unroll
    for (int i = 0; i < 43; ++i) { h = av[i] * h + bv[i]; obuf[(size_t)(t0 + i) * 2048] = h; }
  }
  if (seg == 15) p.out[O_PL + (size_t)(l * 4 + b) * 512 + c] = h;
  __syncthreads();
}

__device__ __forceinline__ void scan_lru_sample(CP& p, int l, int b, int wv) {
  const int c = opaque_tid(wv);
  const float* prep = (const float*)(p.ws + WS_PREP) + (size_t)(NPR + b * 4) * PREP_LD;
  float* obuf = (float*)(p.ws + WS_OBUF) + (size_t)(NPR + b * 4) * 2048 + 512 + c;
  float h = p.in[4][(size_t)(l * 128 + b) * 512 + c];
#pragma unroll
  for (int t = 0; t < 4; ++t) { h = prep[(size_t)t * PREP_LD + P_LA + c] * h + prep[(size_t)t * PREP_LD + P_LB + c]; obuf[(size_t)t * 2048] = h; }
  p.out[O_SL + (size_t)(l * 128 + b) * 512 + c] = h;
}

__device__ __forceinline__ void scan_item2(CP& p, int l, int k, int wv) {
  if (k < 64) scan_lru_prompt(p, l, k >> 4, k & 15, wv);
  else if (k < 320) scan_sample<0>(p, l, k - 64, wv);
  else if (k < 448) scan_sample<1>(p, l, k - 320, wv);
  else if (k < 576) scan_sample<2>(p, l, k - 448, wv);
  else scan_lru_sample(p, l, k - 576, wv);
}

__device__ __forceinline__ void phase_scan(CP& p, int l, int wv) {
  extern __shared__ __attribute__((aligned(16))) unsigned char smem_raw[];
  float* sm = (float*)smem_raw;
  const int G = gridDim.x;
  const int tid = opaque_tid(wv);
  const int role = tid >> 8, rt = tid & 255;
#pragma unroll 1
  for (int it = blockIdx.x; it < 32; it += G) {
    if (role == 0) scan_prompt_delta_mfma(p, l, it >> 1, it & 1, sm, rt);
    else { for (int i = 0; i < NST + 1; ++i) __syncthreads(); }
    __syncthreads();
  }
#pragma unroll 1
  for (int it = blockIdx.x < 32 ? blockIdx.x + ((32 + G - 1 - blockIdx.x) / G) * G : blockIdx.x; it < 64; it += G) {
    const int i2 = it - 32;
    if (role == 0) scan_prompt_mfma<1>(p, l, i2 >> 1, i2 & 1, sm, rt);
    else scan_prompt_mfma<2>(p, l, i2 >> 1, i2 & 1, sm + 10240, rt);
    __syncthreads();
  }
  if (G >= 128) {
#pragma unroll 1
    for (int k = (int)blockIdx.x - 64; k >= 0 && k < 704; k += G - 64) scan_item2(p, l, k, wv);
    __syncthreads();
  } else {
#pragma unroll 1
    for (int k = blockIdx.x; k < 704; k += G) scan_item2(p, l, k, wv);
    __syncthreads();
  }
  __syncthreads();
}

__device__ __forceinline__ void phase_post(CP& p, int l, int wv) {
  const int tid = opaque_tid(wv), lane = tid & 63, w = tid >> 6;
  const float* obuf = (const float*)(p.ws + WS_OBUF);
  const float* proj = (const float*)(p.ws + WS_PROJ);
  unsigned* mix = (unsigned*)(p.ws + WS_MIX);
  const unsigned short* gb16 = (const unsigned short*)(p.ws + WS_GB16);
  const float2 na = *(const float2*)(p.in[14] + l * 128 + lane * 2);
  const float2 nc = *(const float2*)(p.in[24] + l * 128 + lane * 2);
  for (int r = blockIdx.x * 8 + w; r < MROWS; r += gridDim.x * 8) {
#pragma unroll 4
    for (int seg = 0; seg < 16; ++seg) {
      float2 x = *(const float2*)(obuf + (size_t)r * 2048 + seg * 128 + lane * 2);
      const int ca = C_GATE + seg * 128 + lane * 2;
      float sgx, sgy;
      if (ca >= GCOL0) { const unsigned u = *(const unsigned*)(gb16 + (size_t)r * 2048 + (ca - GCOL0)); sgx = siluf_(__uint_as_float(u << 16)); sgy = siluf_(__uint_as_float(u & 0xffff0000u)); }
      else { const float2 g = *(const float2*)(proj + (size_t)r * LDP + ca); sgx = siluf_(g.x); sgy = siluf_(g.y); }
      const int ty = seg >> 2;
      if (ty != 1) {
        const float ss = wave_allsum(x.x * x.x + x.y * x.y);
        const float sc = rsqrtf(ss * (1.f / 128.f) + 1e-6f);
        x.x *= sc; x.y *= sc;
        if (ty == 0) { x.x *= na.x; x.y *= na.y; }
        else if (ty == 2) { x.x *= nc.x; x.y *= nc.y; }
      }
      mix[(size_t)r * 1024 + seg * 64 + lane] = pack2(x.x * sgx, x.y * sgy);
    }
  }
}

__device__ __forceinline__ void phase_final(CP& p, int wv) {
  const int tid = opaque_tid(wv), lane = tid & 63, w = tid >> 6;
  const float* H = (const float*)(p.ws + WS_H);
  const float4* fw = (const float4*)p.in[26];
  for (int r = blockIdx.x * 8 + w; r < MROWS; r += gridDim.x * 8) {
    float* dst;
    if (r < NPR) { const int b = r / LP, t = r % LP; if (t < 16) continue; dst = p.out + O_YP + ((size_t)b * 2048 + (t - 16)) * D; }
    else dst = p.out + O_YS + (size_t)(r - NPR) * D;
    const float4* src = (const float4*)(H + (size_t)r * D);
    float4 v[8]; float ss = 0.f;
#pragma unroll
    for (int i = 0; i < 8; ++i) v[i] = src[lane + 64 * i];
    if (r >= 8192) {
      const float* pb = (const float*)(p.ws + WS_PB) + ((size_t)(((r >> 8) - 32) * 8) * 8) * 65536 + (size_t)(r & 255) * 256 + lane * 4;
#pragma unroll
      for (int i = 0; i < 8; ++i)
#pragma unroll
        for (int ch = 0; ch < 8; ++ch) { const float4 a = *(const float4*)(pb + (size_t)(i * 8 + ch) * 65536); v[i].x += a.x; v[i].y += a.y; v[i].z += a.z; v[i].w += a.w; }
    }
#pragma unroll
    for (int i = 0; i < 8; ++i) ss += v[i].x * v[i].x + v[i].y * v[i].y + v[i].z * v[i].z + v[i].w * v[i].w;
    ss = wave_allsum(ss);
    const float sc = rsqrtf(ss * (1.f / 2048.f) + 1e-6f);
#pragma unroll
    for (int i = 0; i < 8; ++i) {
      const float4 wv = fw[lane + 64 * i];
      ((float4*)dst)[lane + 64 * i] = make_float4(v[i].x * sc * wv.x, v[i].y * sc * wv.y, v[i].z * sc * wv.z, v[i].w * sc * wv.w);
    }
  }
}

#define XB_TMO      128
#define XB_XCNT(j)  (256  + 64 * (j))
#define XB_XSUB(j)  (1280 + 64 * (j))
#define XB_XGEN(j)  (2304 + 64 * (j))
#define XB_TOP      3328
#define XB_TOPGEN   3392
#define XCD_BAR_WORDS 3456
#define XB_SPIN_CAP (1u << 22)
#define LAS __attribute__((address_space(3)))
__device__ __forceinline__ unsigned xb_ld(unsigned* p)              { return __hip_atomic_load(p, __ATOMIC_RELAXED, __HIP_MEMORY_SCOPE_AGENT); }
__device__ __forceinline__ unsigned xb_add(unsigned* p, unsigned v) { return __hip_atomic_fetch_add(p, v, __ATOMIC_RELAXED, __HIP_MEMORY_SCOPE_AGENT); }
__device__ __forceinline__ unsigned xb_xcc_id() { return (unsigned)__builtin_amdgcn_s_getreg((3 << 11) | 20) & 0xFu; }
#define XB_SPIN(cond, bar) do { unsigned _sp = 0; while (cond) { __builtin_amdgcn_s_sleep(1); \
    if ((++_sp & 255u) == 0u) { if (xb_ld(&(bar)[XB_TMO])) break; if (_sp > XB_SPIN_CAP) { atomicAdd(&(bar)[XB_TMO], 1u); break; } } } } while (0)
__device__ __forceinline__ void xcd_barrier_complete(unsigned* bar, unsigned x, unsigned& nloc, unsigned& nx) {
  const unsigned G = gridDim.x;
  unsigned sum, cnt, mine, sp = 0u;
  for (;;) {
    sum = 0u; cnt = 0u; mine = 0u;
#pragma unroll
    for (unsigned j = 0; j < 16; ++j) { const unsigned c = xb_ld(&bar[XB_XCNT(j)]); sum += c; cnt += (c > 0u) ? 1u : 0u; mine = (j == x) ? c : mine; }
    if (sum == G) break;
    __builtin_amdgcn_s_sleep(1);
    if ((++sp & 255u) == 0u) { if (xb_ld(&bar[XB_TMO])) break; if (sp > XB_SPIN_CAP) { atomicAdd(&bar[XB_TMO], 1u); break; } }
  }
  nloc = mine > 0u ? mine : 1u; nx = cnt > 0u ? cnt : 1u;
}
__device__ __forceinline__ void fast_grid_sync(unsigned* bar, int wv) {
  extern __shared__ __attribute__((aligned(16))) unsigned char smem_raw[];
  asm volatile("s_waitcnt vmcnt(0)" ::: "memory");
  __syncthreads();
  if (wv == 0) {
    if (opaque_tid(wv) == 0) {
      volatile LAS unsigned* st = (volatile LAS unsigned*)(smem_raw + 131072);
      __builtin_amdgcn_s_waitcnt(0);
      const unsigned x = xb_xcc_id();
      unsigned nloc = st[0], nx = st[1];
      if (nloc == 0u) { xcd_barrier_complete(bar, x, nloc, nx); st[0] = nloc; st[1] = nx; }
      const unsigned old = xb_add(&bar[XB_XSUB(x)], 1u);
      const unsigned gen = old / nloc;
      if (old + 1u == (gen + 1u) * nloc) {
        __builtin_amdgcn_fence(__ATOMIC_RELEASE, "agent");
        asm volatile("s_waitcnt vmcnt(0)" ::: "memory");
        const unsigned og = xb_add(&bar[XB_TOP], 1u);
        const unsigned tg = og / nx;
        if (og + 1u == (tg + 1u) * nx) xb_add(&bar[XB_TOPGEN], 1u);
        else XB_SPIN(xb_ld(&bar[XB_TOPGEN]) == tg, bar);
        __builtin_amdgcn_fence(__ATOMIC_ACQUIRE, "agent");
        xb_add(&bar[XB_XGEN(x)], 1u);
        asm volatile("s_waitcnt vmcnt(0)" ::: "memory");
      } else {
        XB_SPIN(xb_ld(&bar[XB_XGEN(x)]) == gen, bar);
        __builtin_amdgcn_fence(__ATOMIC_ACQUIRE, "agent");
        asm volatile("s_waitcnt vmcnt(0)" ::: "memory");
      }
    }
  }
  __syncthreads();
}

__global__ void __launch_bounds__(NTHR) mega(P p_) {
  cg::grid_group grid = cg::this_grid();
  const int wv = __builtin_amdgcn_readfirstlane((int)(threadIdx.x >> 6));
#define GSYNC(j_) fast_grid_sync((unsigned*)((*getp()).ws + WS_BAR), wv)
  { extern __shared__ __attribute__((aligned(16))) unsigned char smem_raw[];
    if (wv == 0 && opaque_tid(wv) == 0) { volatile LAS unsigned* st = (volatile LAS unsigned*)(smem_raw + 131072); st[0] = 0u; st[1] = 0u;
      (void)xb_add(&((unsigned*)((*getp()).ws + WS_BAR))[XB_XCNT(xb_xcc_id())], 1u); }
    __syncthreads(); }
  phase_convert(*getp(), wv);
  if ((*getp()).pad != 0) grid.sync();
  GSYNC(0);
#pragma unroll 1
  for (int l = 0; l < 4; ++l) {
    phase_norm(*getp(), wv, l > 0);
    GSYNC(1);
    { CP& p = *getp();
      phase_gemm<0>((const bf16*)(p.ws + WS_XN), (const bf16*)(p.ws + WS_WTIN) + (size_t)l * LDW * 2048, (float*)(p.ws + WS_PROJ), p.mpad, p.ldp, wv, p.ldq, (unsigned short*)(p.ws + WS_GB16)); }
    {
      const int G_ = gridDim.x, nt4 = 875 - 3 * G_;
      if (l < 3 && G_ == 256 && (int)blockIdx.x >= nt4) convert_weights(*getp(), wv, (l + 1) * CV_TL, (l + 2) * CV_TL, (int)blockIdx.x - nt4, G_ - nt4);
      else if (l < 3 && G_ != 256) convert_weights(*getp(), wv, (l + 1) * CV_TL, (l + 2) * CV_TL, blockIdx.x, G_); }
    GSYNC(2);
    phase_prep(*getp(), l, wv);
    GSYNC(3);
    phase_prep2(*getp(), wv);
    GSYNC(4);
    phase_scan(*getp(), l, wv);
    GSYNC(5);
    phase_post(*getp(), l, wv);
    GSYNC(6);
    { CP& p = *getp();
      phase_gemm_out((const bf16*)(p.ws + WS_MIX), (const bf16*)(p.ws + WS_WTOUT) + (size_t)l * 2048 * 2048, (float*)(p.ws + WS_H), (float*)(p.ws + WS_PB), p.mpad, p.dm, wv); }
    GSYNC(7);
  }
  phase_final(*getp(), wv);
}

#undef GSYNC
extern "C" void kernel_launch(void* const* d_in, const int* in_sizes, int n_in, void* d_out, int out_size, void* d_ws, size_t ws_size,
                              hipStream_t stream) {
  static int grid = 0;
  if (grid == 0) {
    int dev = 0, cus = 0, per_cu = 0;
    hipGetDevice(&dev);
    hipDeviceGetAttribute(&cus, hipDeviceAttributeMultiprocessorCount, dev);
    hipFuncSetAttribute((const void*)mega, hipFuncAttributeMaxDynamicSharedMemorySize, LDS_BYTES);
    hipOccupancyMaxActiveBlocksPerMultiprocessor(&per_cu, (const void*)mega, NTHR, LDS_BYTES);
    if (per_cu < 1) per_cu = 1;
    if (per_cu > 1) per_cu = 1;
    grid = cus * per_cu;
    if (ws_size < WS_END) { fprintf(stderr, "workspace too small: %zu < %zu\n", ws_size, (size_t)WS_END); }
  }
  P p{};
  for (int i = 0; i < 27; ++i) p.in[i] = (const float*)d_in[i];
  p.out = (float*)d_out;
  p.ws = (unsigned char*)d_ws;
  p.mpad = MPAD; p.ldp = LDW; p.dm = D; p.pad = 0; p.ldq = LDP; p.pad2 = 0;
  (void)hipMemsetAsync((unsigned char*)d_ws + WS_BAR, 0, 16384, stream);
  void* args[] = {&p};
  hipError_t e = hipLaunchCooperativeKernel((const void*)mega, dim3(grid), dim3(NTHR), args, LDS_BYTES, stream);
  if (e != hipSuccess) fprintf(stderr, "cooperative launch failed: %s (grid %d)\n", hipGetErrorString(e), grid);
}
```

```cpp
#include <hip/hip_runtime.h>
#include <hip/hip_bf16.h>
#include <hip/hip_cooperative_groups.h>
#include <cstdio>
namespace cg = cooperative_groups;

using bf16 = __hip_bfloat16;
using bf16x8 = __attribute__((ext_vector_type(8))) short;
using f32x4 = __attribute__((ext_vector_type(4))) float;

constexpr int D = 2048;
constexpr int LP = 2064;
constexpr int NPR = 4 * LP;
constexpr int NSR = 512;
constexpr int MROWS = NPR + NSR;
constexpr int MPAD = 8960;
constexpr int INW = 6168;
constexpr int LDW = 6400;
constexpr int LDP = 4352;
constexpr int GCOL0 = 4352;
constexpr int NTHR = 512;
constexpr int LDS_BYTES = 131072 + 64;

constexpr int C_ALPHA = 1536, C_BETA = 1540, C_XB = 1544, C_QC = 2056, C_KC = 2312, C_VC = 2568, C_RC = 3080,
              C_QD = 3096, C_KD = 3352, C_VD = 3608, C_GATE = 4120;
constexpr int P_QA = 0, P_KA = 512, P_VA = 1024, P_AB = 1536, P_LA = 1544, P_LB = 2056, P_QC = 2568, P_KC = 2824,
              P_AC = 3080, P_QD = 3336, P_KD = 3592, P_WA = 3848, P_KH = 4360, P_GC = 4872, P_DM = 4880, PREP_LD = 4944;

constexpr size_t O_YP = 0;
constexpr size_t O_YS = O_YP + (size_t)4 * 2048 * 2048;
constexpr size_t O_PD = O_YS + (size_t)128 * 4 * 2048;
constexpr size_t O_PDC = O_PD + (size_t)4 * 4 * 4 * 128 * 128;
constexpr size_t O_PL = O_PDC + (size_t)4 * 4 * 3 * 1536;
constexpr size_t O_PLC = O_PL + (size_t)4 * 4 * 512;
constexpr size_t O_PG = O_PLC + (size_t)4 * 4 * 3 * 512;
constexpr size_t O_PR = O_PG + (size_t)4 * 4 * 4 * 64 * 128;
constexpr size_t O_SD = O_PR + (size_t)4 * 4 * 4 * 64 * 128;
constexpr size_t O_SDC = O_SD + (size_t)4 * 128 * 4 * 128 * 128;
constexpr size_t O_SL = O_SDC + (size_t)4 * 128 * 3 * 1536;
constexpr size_t O_SLC = O_SL + (size_t)4 * 128 * 512;
constexpr size_t O_SG = O_SLC + (size_t)4 * 128 * 3 * 512;
constexpr size_t O_SR = O_SG + (size_t)4 * 128 * 4 * 64 * 128;

constexpr size_t WS_WTIN = 0;
constexpr size_t WS_WTOUT = WS_WTIN + (size_t)4 * LDW * 2048 * 2;
constexpr size_t WS_H = WS_WTOUT + (size_t)4 * 2048 * 2048 * 2;
constexpr size_t WS_XN = WS_H + (size_t)MPAD * 2048 * 4;
constexpr size_t WS_PROJ = WS_XN + (size_t)MPAD * 2048 * 2;
constexpr size_t WS_PREP = WS_PROJ + (size_t)MPAD * LDP * 4;
constexpr size_t WS_OBUF = WS_PREP + (size_t)MROWS * PREP_LD * 4;
constexpr size_t WS_MIX = WS_XN;
constexpr size_t WS_WTG = WS_OBUF + (size_t)MROWS * 2048 * 4;
constexpr size_t WS_GDEC = WS_WTG + (size_t)4 * 4 * 2 * 128 * 128 * 2;
constexpr size_t WS_BAR = WS_GDEC + (size_t)(MROWS / 16) * 256 * 4;
constexpr size_t WS_PB = WS_BAR + 16384;
constexpr size_t WS_GB16 = WS_PB + (size_t)24 * 8 * 65536 * 4;
constexpr size_t WS_END = WS_GB16 + (size_t)MPAD * 2048 * 2;

struct P { const float* in[27]; float* out; unsigned char* ws; int mpad, ldp, dm, pad, ldq, pad2; };
typedef const __attribute__((address_space(4))) P CP;
__device__ __forceinline__ CP* getp() { CP* pp = (CP*)__builtin_amdgcn_kernarg_segment_ptr(); asm volatile("" : "+s"(pp)); return pp; }

__device__ __forceinline__ unsigned short f2bf(float f) {
  unsigned u = __float_as_uint(f);
  u += 0x7fffu + ((u >> 16) & 1u);
  return (unsigned short)(u >> 16);
}
typedef float cvf2_t __attribute__((ext_vector_type(2)));
typedef __bf16 cvb2_t __attribute__((ext_vector_type(2)));
__device__ __forceinline__ unsigned cvtpk(float lo, float hi) { cvf2_t v = {lo, hi}; return __builtin_bit_cast(unsigned, __builtin_convertvector(v, cvb2_t)); }
__device__ __forceinline__ unsigned pack2(float a, float b) { return (unsigned)f2bf(a) | ((unsigned)f2bf(b) << 16); }
__device__ __forceinline__ float sigmoidf_(float x) { return __builtin_amdgcn_rcpf(1.f + __expf(-x)); }
__device__ __forceinline__ float siluf_(float x) { return x * __builtin_amdgcn_rcpf(1.f + __expf(-x)); }
__device__ __forceinline__ float softplusf_(float x) {
  const float e = __expf(fminf(x, 15.f));
  const float mid = __logf(1.f + e);
  return x > 15.f ? x : (x < -6.f ? e * (1.f - 0.5f * e) : mid);
}
template <int CTRL> __device__ __forceinline__ float dpp_f(float x) {
  return __builtin_bit_cast(float, __builtin_amdgcn_update_dpp(0, __builtin_bit_cast(int, x), CTRL, 0xf, 0xf, true));
}

typedef __attribute__((ext_vector_type(4))) unsigned u32x4;
__device__ __forceinline__ bf16x8 mkfrag(unsigned a, unsigned b, unsigned c, unsigned d) { u32x4 t = {a, b, c, d}; return __builtin_bit_cast(bf16x8, t); }
__device__ __forceinline__ float row16_allsum(float x) {
  x += dpp_f<0x128>(x);
  x += dpp_f<0x124>(x);
  x += dpp_f<0x122>(x);
  x += dpp_f<0x121>(x);
  return x;
}
__device__ __forceinline__ float wave_allsum(float x) {
  x = row16_allsum(x);
  const int xi = __builtin_bit_cast(int, x);
  const float r0 = __builtin_bit_cast(float, __builtin_amdgcn_readlane(xi, 0));
  const float r1 = __builtin_bit_cast(float, __builtin_amdgcn_readlane(xi, 16));
  const float r2 = __builtin_bit_cast(float, __builtin_amdgcn_readlane(xi, 32));
  const float r3 = __builtin_bit_cast(float, __builtin_amdgcn_readlane(xi, 48));
  return (r0 + r1) + (r2 + r3);
}

__device__ __forceinline__ int opaque_tid(int wv) { unsigned m = ~0u; asm volatile("" : "+s"(m)); int t = wv * 64 + (int)__builtin_amdgcn_mbcnt_hi(m, __builtin_amdgcn_mbcnt_lo(m, 0u)); asm volatile("" : "+v"(t)); return t; }

constexpr int CV_TIN = 32 * 100, CV_TOUT = 32 * 32, CV_TL = CV_TIN + CV_TOUT;
__device__ __forceinline__ void convert_weights(CP& p, int wv, int t_lo, int t_hi, int bidx, int nb) {
  extern __shared__ __attribute__((aligned(16))) unsigned char smem_raw[];
  float* sm = (float*)smem_raw;
  const int tid = opaque_tid(wv);
  bf16* wtin = (bf16*)(p.ws + WS_WTIN);
  bf16* wtout = (bf16*)(p.ws + WS_WTOUT);
  constexpr int TIN = CV_TIN, TL = CV_TL;
  {
    const int kk0 = tid >> 4, n4 = (tid & 15) * 4;
    const int nn = tid >> 3, k8 = (tid & 7) * 8;
    float4 va = make_float4(0.f, 0.f, 0.f, 0.f), vb = va; float sa = 1.f, sb = 1.f;
#define CV_DECODE(t_) \
    const int l_ = (t_) / TL; int r_ = (t_) % TL; const float* src_; int nsrc_, kt_, nt_; const float* nw_; unsigned short* dst_; \
    if (r_ < TIN) { kt_ = r_ / 100; nt_ = r_ % 100; src_ = p.in[10] + (size_t)l_ * 2048 * INW; nsrc_ = INW; \
                    dst_ = (unsigned short*)(wtin + (size_t)l_ * LDW * 2048); nw_ = p.in[9] + l_ * 2048; } \
    else { r_ -= TIN; kt_ = r_ / 32; nt_ = r_ % 32; src_ = p.in[25] + (size_t)l_ * 2048 * 2048; nsrc_ = 2048; \
           dst_ = (unsigned short*)(wtout + (size_t)l_ * 2048 * 2048); nw_ = nullptr; }
#define CV_LOAD(t_) do { CV_DECODE(t_) (void)dst_; \
      const int n_ = nt_ * 64 + n4, ka_ = kt_ * 64 + kk0, kb_ = ka_ + 32; \
      va = make_float4(0.f, 0.f, 0.f, 0.f); vb = va; \
      if (n_ < nsrc_) { va = *(const float4*)(src_ + (size_t)ka_ * nsrc_ + n_); vb = *(const float4*)(src_ + (size_t)kb_ * nsrc_ + n_); } \
      sa = nw_ ? nw_[ka_] : 1.f; sb = nw_ ? nw_[kb_] : 1.f; } while (0)
    int t = t_lo + bidx;
    if (t < t_hi) CV_LOAD(t);
    int cur = 0;
    for (; t < t_hi; t += nb) {
      float* sb_ = sm + cur * (64 * 65);
      sb_[kk0 * 65 + n4 + 0] = va.x * sa; sb_[kk0 * 65 + n4 + 1] = va.y * sa; sb_[kk0 * 65 + n4 + 2] = va.z * sa; sb_[kk0 * 65 + n4 + 3] = va.w * sa;
      sb_[(kk0 + 32) * 65 + n4 + 0] = vb.x * sb; sb_[(kk0 + 32) * 65 + n4 + 1] = vb.y * sb; sb_[(kk0 + 32) * 65 + n4 + 2] = vb.z * sb; sb_[(kk0 + 32) * 65 + n4 + 3] = vb.w * sb;
      if (t + nb < t_hi) CV_LOAD(t + nb);
      __syncthreads();
      {
        CV_DECODE(t) (void)src_; (void)nsrc_; (void)nw_;
        uint4 o;
        o.x = pack2(sb_[(k8 + 0) * 65 + nn], sb_[(k8 + 1) * 65 + nn]);
        o.y = pack2(sb_[(k8 + 2) * 65 + nn], sb_[(k8 + 3) * 65 + nn]);
        o.z = pack2(sb_[(k8 + 4) * 65 + nn], sb_[(k8 + 5) * 65 + nn]);
        o.w = pack2(sb_[(k8 + 6) * 65 + nn], sb_[(k8 + 7) * 65 + nn]);
        *(uint4*)(dst_ + (size_t)(nt_ * 64 + nn) * 2048 + kt_ * 64 + k8) = o;
      }
      cur ^= 1;
    }
#undef CV_LOAD
#undef CV_DECODE
    __syncthreads();
  }
}

__device__ __forceinline__ void phase_convert(CP& p, int wv) {
  const int tid = opaque_tid(wv);
  convert_weights(p, wv, 0, CV_TL, blockIdx.x, gridDim.x);
  float* H = (float*)(p.ws + WS_H);
  const size_t gtid = (size_t)blockIdx.x * NTHR + tid, gsz = (size_t)gridDim.x * NTHR;
  for (size_t idx = gtid; idx < (size_t)MPAD * 512; idx += gsz) {
    const int r = (int)(idx >> 9), c4 = (int)(idx & 511) * 4;
    float4 v = make_float4(0.f, 0.f, 0.f, 0.f);
    if (r < NPR) { const int b = r / LP, t = r % LP;
      v = t < 16 ? *(const float4*)(p.in[8] + (size_t)t * D + c4) : *(const float4*)(p.in[0] + ((size_t)b * 2048 + (t - 16)) * D + c4); }
    else if (r < MROWS) v = *(const float4*)(p.in[1] + (size_t)(r - NPR) * D + c4);
    *(float4*)(H + (size_t)r * D + c4) = v;
  }
  {
    unsigned short* wtg = (unsigned short*)(p.ws + WS_WTG);
    for (size_t idx = gtid; idx < (size_t)4 * 4 * 2 * 128 * 128; idx += gsz) {
      const int c = (int)(idx & 127), d = (int)((idx >> 7) & 127), g = (int)((idx >> 14) & 1), blk = (int)((idx >> 15) & 3), l = (int)(idx >> 17);
      const float* srcg = (g == 0 ? p.in[17] : p.in[19]) + ((size_t)((l * 4 + blk) * 128 + c)) * 128 + d;
      wtg[idx] = f2bf(*srcg);
    }
  }
  unsigned* mixz = (unsigned*)(p.ws + WS_MIX + (size_t)MROWS * 2048 * 2);
  for (size_t idx = gtid; idx < (size_t)(MPAD - MROWS) * 1024; idx += gsz) mixz[idx] = 0u;
}

__device__ __forceinline__ void phase_norm(CP& p, int wv, int fix) {
  const int tid = opaque_tid(wv), lane = tid & 63, w = tid >> 6;
  float* H = (float*)(p.ws + WS_H);
  const float* PB = (const float*)(p.ws + WS_PB);
  unsigned short* XN = (unsigned short*)(p.ws + WS_XN);
  for (int r = blockIdx.x * 8 + w; r < MPAD; r += gridDim.x * 8) {
    uint2* dst = (uint2*)(XN + (size_t)r * D);
    if (r >= MROWS) {
#pragma unroll
      for (int i = 0; i < 8; ++i) dst[lane + 64 * i] = make_uint2(0u, 0u);
      continue;
    }
    float4* src = (float4*)(H + (size_t)r * D);
    float4 v[8]; float ss = 0.f;
#pragma unroll
    for (int i = 0; i < 8; ++i) v[i] = src[lane + 64 * i];
    if (fix && r >= 8192) {
      const float* pb = PB + ((size_t)(((r >> 8) - 32) * 8) * 8) * 65536 + (size_t)(r & 255) * 256 + lane * 4;
#pragma unroll
      for (int i = 0; i < 8; ++i) {
#pragma unroll
        for (int ch = 0; ch < 8; ++ch) { const float4 a = *(const float4*)(pb + (size_t)(i * 8 + ch) * 65536); v[i].x += a.x; v[i].y += a.y; v[i].z += a.z; v[i].w += a.w; }
        src[lane + 64 * i] = v[i];
      }
    }
#pragma unroll
    for (int i = 0; i < 8; ++i) ss += v[i].x * v[i].x + v[i].y * v[i].y + v[i].z * v[i].z + v[i].w * v[i].w;
    ss = wave_allsum(ss);
    const float sc = rsqrtf(ss * (1.f / 2048.f) + 1e-6f);
#pragma unroll
    for (int i = 0; i < 8; ++i) dst[lane + 64 * i] = make_uint2(pack2(v[i].x * sc, v[i].y * sc), pack2(v[i].z * sc, v[i].w * sc));
  }
}

constexpr int BM = 256, BK = 64, HALF = 128, NXCD = 8, WGM = 8, HT = HALF * BK;
__device__ __forceinline__ int lds_byte(int r, int c) {
  int st = (r >> 4) * 2 + (c >> 5), rr = r & 15, cc = c & 31, ob = rr * 64 + cc * 2;
  return st * 1024 + (ob ^ (((ob >> 9) & 1) << 5));
}
__device__ __forceinline__ void stage_rc(int b, int& R, int& C) {
  int st = b / 1024, sb = b % 1024, swz = sb ^ (((sb >> 9) & 1) << 5);
  R = (st >> 1) * 16 + swz / 64; C = (st & 1) * 32 + (swz % 64) / 2;
}

template <int MODE> __device__ __forceinline__ void gemm_tile(const bf16*A,const bf16*Bt,float*C,int M,int N,int tile,int wv,int pmo,int pno,int kt0,int ntk,int ldc,int cpart,unsigned short*C16=nullptr){ constexpr int K=2048;
  extern __shared__ __attribute__((aligned(16))) bf16 shm[];
  const int tix = opaque_tid(wv);
  #define SA(b,h) (shm+((b)*2+(h))*HT)
  #define SB(b,h) (shm+(4+(b)*2+(h))*HT)
  unsigned soff0,soff1; {int _r,_c; stage_rc(tix*16,_r,_c); soff0=_r*K+_c; stage_rc(tix*16+8192,_r,_c); soff1=_r*K+_c;}
  #define STAGE(P,BASE,br,kt) do{const bf16* _gb=BASE+(long)(br)*K+(long)((kt)+kt0)*BK; \
      __builtin_amdgcn_global_load_lds((const unsigned*)(_gb+soff0),(unsigned*)((char*)(P)+tix*16),16,0,0); \
      __builtin_amdgcn_global_load_lds((const unsigned*)(_gb+soff1),(unsigned*)((char*)(P)+tix*16+8192),16,0,0);}while(0)
  #define LDA(dst,b,h) for(int m=0;m<4;++m)for(int k=0;k<2;++k) \
    dst[m][k]=*reinterpret_cast<const bf16x8*>((char*)SA(b,h)+lds_byte(wr*64+m*16+fr,k*32+fq*8))
  #define LDB(dst,b,h) for(int n=0;n<2;++n)for(int k=0;k<2;++k) \
    dst[n][k]=*reinterpret_cast<const bf16x8*>((char*)SB(b,h)+lds_byte(wc*32+n*16+fr,k*32+fq*8))
  #define MMA(ai,bj,At,Bt) do{__builtin_amdgcn_s_setprio(1); \
    for(int m=0;m<4;++m)for(int n=0;n<2;++n)for(int k=0;k<2;++k) \
      acc[ai][bj][m][n]=__builtin_amdgcn_mfma_f32_16x16x32_bf16(At[m][k],Bt[n][k],acc[ai][bj][m][n],0,0,0); \
    __builtin_amdgcn_s_setprio(0);}while(0)
  #define WAIT_V(n) asm volatile("s_waitcnt vmcnt(" #n ")":::"memory")
  #define WAIT_L(n) asm volatile("s_waitcnt lgkmcnt(" #n ")":::"memory")
  #define BAR __builtin_amdgcn_s_barrier()
  #define SCHED __builtin_amdgcn_sched_barrier(0)

  int nM=M/BM,nN=N/BM,nwg=nM*nN,wgid=tile;
  {int q=nwg/NXCD,r=nwg%NXCD,xcd=wgid%NXCD,off=wgid/NXCD;
   wgid=(xcd<r?xcd*(q+1):r*(q+1)+(xcd-r)*q)+off;}
  int nig=WGM*nN,gid=wgid/nig,fm=gid*WGM,gsz=min(nM-fm,WGM);
  int pm=fm+((wgid%nig)%gsz),pn=(wgid%nig)/gsz; if(pmo>=0){pm=pmo;pn=pno;} int brow=pm*BM,bcol=pn*BM;
  int wid=tix>>6,lane=tix&63,wr=wid>>2,wc=wid&3,fr=lane&15,fq=lane>>4;
  f32x4 acc[2][2][4][2]={};
  bf16x8 At[4][2],B0[2][2],B1[2][2];
  int nt=ntk;
  STAGE(SB(0,0),Bt,bcol,0); STAGE(SA(0,0),A,brow,0);
  STAGE(SB(0,1),Bt,bcol+HALF,0); STAGE(SA(0,1),A,brow+HALF,0);
  if(wr==1)BAR;
  WAIT_V(4); BAR;
  STAGE(SB(1,0),Bt,bcol,1); STAGE(SA(1,0),A,brow,1); STAGE(SB(1,1),Bt,bcol+HALF,1);
  WAIT_V(6); BAR;
  for(int t=0;t<nt-2;t+=2){
    LDB(B0,0,0); SCHED; LDA(At,0,0); STAGE(SA(1,1),A,brow+HALF,t+1);
    WAIT_L(8); BAR; WAIT_L(0); MMA(0,0,At,B0); BAR; SCHED;
    LDB(B1,0,1); STAGE(SB(0,0),Bt,bcol,t+2);
    BAR; WAIT_L(0); MMA(0,1,At,B1); BAR;
    LDA(At,0,1); STAGE(SA(0,0),A,brow,t+2);
    BAR; WAIT_L(0); MMA(1,0,At,B0); BAR; SCHED;
    STAGE(SB(0,1),Bt,bcol+HALF,t+2);
    WAIT_V(6); BAR; MMA(1,1,At,B1); BAR;
    LDB(B0,1,0); SCHED; LDA(At,1,0); STAGE(SA(0,1),A,brow+HALF,t+2);
    WAIT_L(8); BAR; WAIT_L(0); MMA(0,0,At,B0); BAR; SCHED;
    LDB(B1,1,1); STAGE(SB(1,0),Bt,bcol,t+3);
    BAR; WAIT_L(0); MMA(0,1,At,B1); BAR;
    LDA(At,1,1); STAGE(SA(1,0),A,brow,t+3);
    BAR; WAIT_L(0); MMA(1,0,At,B0); BAR; SCHED;
    STAGE(SB(1,1),Bt,bcol+HALF,t+3);
    WAIT_V(6); BAR; MMA(1,1,At,B1); BAR;
  }
  { LDB(B0,0,0); LDA(At,0,0); STAGE(SA(1,1),A,brow+HALF,nt-1);
    BAR; WAIT_L(0); MMA(0,0,At,B0); BAR;
    LDB(B1,0,1); BAR; WAIT_L(0); MMA(0,1,At,B1); BAR;
    LDA(At,0,1); WAIT_V(4); BAR; WAIT_L(0); MMA(1,0,At,B0); MMA(1,1,At,B1); BAR; }
  { LDB(B0,1,0); LDA(At,1,0); WAIT_V(2); BAR; WAIT_L(0); MMA(0,0,At,B0); BAR;
    LDB(B1,1,1); WAIT_V(0); BAR; WAIT_L(0); MMA(0,1,At,B1); BAR;
    LDA(At,1,1); BAR; WAIT_L(0); MMA(1,0,At,B0); MMA(1,1,At,B1); BAR; }
  if(wr==0)BAR;
  {
    float* eps = (float*)shm;
    const int er = tix >> 5, ec = (tix & 31) * 4;
    float* cbase = C + (long)((cpart ? 0 : brow) + er) * ldc + ((cpart ? 0 : bcol) + ec);
#pragma unroll
    for (int ai = 0; ai < 2; ++ai)
#pragma unroll
      for (int bj = 0; bj < 2; ++bj) {
        __syncthreads();
#pragma unroll
        for (int m = 0; m < 4; ++m)
#pragma unroll
          for (int n = 0; n < 2; ++n)
#pragma unroll
            for (int j = 0; j < 4; ++j) eps[(wr * 64 + m * 16 + fq * 4 + j) * 132 + wc * 32 + n * 16 + fr] = acc[ai][bj][m][n][j];
        __syncthreads();
        if (MODE == 0 && C16 != nullptr && pn >= 17) {
#pragma unroll
          for (int i = 0; i < 8; ++i) {
            const float4 v = *(const float4*)(eps + (er + 16 * i) * 132 + ec);
            uint2 o; o.x = cvtpk(v.x, v.y); o.y = cvtpk(v.z, v.w);
            *(uint2*)(C16 + (long)(brow + er + ai * HALF + 16 * i) * 2048 + ((pn - 17) * 256 + bj * HALF + ec)) = o;
          }
        } else {
#pragma unroll
          for (int i = 0; i < 8; ++i) {
            float4 v = *(const float4*)(eps + (er + 16 * i) * 132 + ec);
            float4* gp = (float4*)(cbase + (long)(ai * HALF + 16 * i) * ldc + bj * HALF);
            if (MODE == 1) { const float4 o = *gp; v.x += o.x; v.y += o.y; v.z += o.z; v.w += o.w; }
            *gp = v;
          }
        }
      }
    __syncthreads();
  }
}
#undef SA
#undef SB
#undef STAGE
#undef LDA
#undef LDB
#undef MMA
template <int MODE> __device__ __forceinline__ void phase_gemm(const bf16* A, const bf16* Bt, float* C, int M, int N, int wv, int ldc, unsigned short* C16) {
  const int nwg = (M / 256) * (N / 256);
  for (int t = blockIdx.x; t < nwg; t += gridDim.x) gemm_tile<MODE>(A, Bt, C, M, N, t, wv, -1, 0, 0, 32, ldc, 0, C16);
  __syncthreads();
}

__device__ __forceinline__ void phase_gemm_out(const bf16* A, const bf16* Bt, float* H, float* PB, int M, int N, int wv) {
#pragma unroll 1
  for (int t = blockIdx.x; t < 256; t += gridDim.x) gemm_tile<1>(A, Bt, H, M, N, t, wv, t >> 3, t & 7, 0, 32, N, 0);
#pragma unroll 1
  for (int i = blockIdx.x; i < 192; i += gridDim.x) {
    const int lt = i >> 3, ch = i & 7;
    gemm_tile<0>(A, Bt, PB + (size_t)i * 65536, M, N, 0, wv, 32 + (lt >> 3), lt & 7, ch * 4, 4, 256, 1);
  }
  __syncthreads();
}

__device__ __forceinline__ void phase_prep(CP& p, int l, int wv) {
  extern __shared__ __attribute__((aligned(16))) unsigned char smem_raw[];
  float* xs_t = (float*)smem_raw;
  unsigned short* xs16 = (unsigned short*)(smem_raw + 40960);
  float* gl = (float*)(smem_raw + 57600);
  const unsigned short* wtg = (const unsigned short*)(p.ws + WS_WTG);
  const int tid = opaque_tid(wv), lane = tid & 63, w = tid >> 6;
  const float* proj = (const float*)(p.ws + WS_PROJ);
  float* prep = (float*)(p.ws + WS_PREP);
  const float* conv_a = p.in[11] + (size_t)l * 4 * 1536;
  const float* cst_a = p.in[3] + (size_t)l * 128 * 3 * 1536;
  const float* conv_b = p.in[15] + (size_t)l * 4 * 512;
  const float* cbb = p.in[16] + (size_t)l * 512;
  const float* cst_b = p.in[5] + (size_t)l * 128 * 3 * 512;
  const float* wa = p.in[17] + (size_t)l * 4 * 128 * 128;
  const float* ba = p.in[18] + (size_t)l * 512;
  const float* wx = p.in[19] + (size_t)l * 4 * 128 * 128;
  const float* bx = p.in[20] + (size_t)l * 512;
  const float* lam = p.in[21] + (size_t)l * 512;
  const float* w2 = p.in[22] + (size_t)l * 16 * 256;
  const float* b2 = p.in[23] + (size_t)l * 256;
  const float* a_log = p.in[12] + l * 4;
  const float* dt_bias = p.in[13] + l * 4;

  for (int tt = blockIdx.x; tt < MROWS / 16; tt += gridDim.x) {
    const int r0 = tt * 16;
    const bool pr = r0 < NPR;
    const int t0 = pr ? (r0 % LP) : 0;
    const int s0 = r0 - NPR;
    if (tid < 64) {
      const int i = tid >> 2, hh = tid & 3;
      const float* pr_ = proj + (size_t)(r0 + i) * LDP;
      const float g = -expf(a_log[hh]) * softplusf_(pr_[C_ALPHA + hh] + dt_bias[hh]);
      prep[(size_t)(r0 + i) * PREP_LD + P_AB + hh] = expf(g);
      prep[(size_t)(r0 + i) * PREP_LD + P_AB + 4 + hh] = sigmoidf_(pr_[C_BETA + hh]);
    }
    {
      const int c = tid;
      const float w0 = conv_b[0 * 512 + c], w1 = conv_b[1 * 512 + c], w2_ = conv_b[2 * 512 + c], w3 = conv_b[3 * 512 + c];
      const float bias = cbb[c];
      if (pr) {
        float xw[19];
#pragma unroll
        for (int q = 0; q < 19; ++q) {
          const int t = t0 - 3 + q;
          xw[q] = 0.f;
          if (t >= 0) xw[q] = proj[(size_t)(r0 - 3 + q) * LDP + C_XB + c];
        }
#pragma unroll
        for (int i = 0; i < 16; ++i) { const float xv_ = bias + w3 * xw[i + 3] + w2_ * xw[i + 2] + w1 * xw[i + 1] + w0 * xw[i]; xs_t[c * 20 + i] = xv_; xs16[i * 520 + c] = f2bf(xv_); }
      } else {
#pragma unroll
        for (int bq = 0; bq < 4; ++bq) {
          const int bb = (s0 >> 2) + bq;
          float xw[7];
#pragma unroll
          for (int q = 0; q < 3; ++q) xw[q] = cst_b[((size_t)bb * 3 + q) * 512 + c];
#pragma unroll
          for (int q = 0; q < 4; ++q) xw[3 + q] = proj[(size_t)(r0 + bq * 4 + q) * LDP + C_XB + c];
#pragma unroll
          for (int q = 0; q < 4; ++q) { const float xv_ = bias + w3 * xw[q + 3] + w2_ * xw[q + 2] + w1 * xw[q + 1] + w0 * xw[q]; xs_t[c * 20 + bq * 4 + q] = xv_; xs16[(bq * 4 + q) * 520 + c] = f2bf(xv_); }
        }
      }
    }
    __syncthreads();
    {
      const int blk = w >> 1, g = w & 1;
      const unsigned short* wg = wtg + ((size_t)((l * 4 + blk) * 2 + g) * 128) * 128;
      const int mrow = lane & 15, q = lane >> 4;
      bf16x8 afr[4];
#pragma unroll
      for (int ks = 0; ks < 4; ++ks) afr[ks] = *(const bf16x8*)(xs16 + mrow * 520 + blk * 128 + ks * 32 + q * 8);
      f32x4 acc[8];
#pragma unroll
      for (int nt = 0; nt < 8; ++nt) {
        acc[nt] = (f32x4){0.f, 0.f, 0.f, 0.f};
#pragma unroll
        for (int ks = 0; ks < 4; ++ks) {
          const bf16x8 bfr = *(const bf16x8*)(wg + (size_t)(nt * 16 + mrow) * 128 + ks * 32 + q * 8);
          acc[nt] = __builtin_amdgcn_mfma_f32_16x16x32_bf16(afr[ks], bfr, acc[nt], 0, 0, 0);
        }
      }
#pragma unroll
      for (int nt = 0; nt < 8; ++nt)
#pragma unroll
        for (int jj = 0; jj < 4; ++jj) gl[(g * 16 + q * 4 + jj) * 512 + blk * 128 + nt * 16 + mrow] = acc[nt][jj];
    }
    __syncthreads();
    {
      const int ch = tid;
      const float bav = ba[ch], bxv = bx[ch];
      const float sp = softplusf_(-lam[ch]);
#pragma unroll
      for (int i = 0; i < 16; ++i) {
        const float xb = xs_t[ch * 20 + i];
        const float rg = sigmoidf_(gl[i * 512 + ch] + bav), ig = sigmoidf_(gl[(16 + i) * 512 + ch] + bxv);
        const float log_a = -8.f * rg * sp;
        const float a = __expf(log_a);
        const float x2 = 2.f * log_a;
        const float om = x2 > -0.02f ? -x2 * (1.f + x2 * (0.5f + x2 * (1.f / 6.f))) : 1.f - a * a;
        const float bc = sqrtf(om) * (ig * xb);
        prep[(size_t)(r0 + i) * PREP_LD + P_LA + ch] = a;
        prep[(size_t)(r0 + i) * PREP_LD + P_LB + ch] = bc;
      }
    }
    __syncthreads();
  }
  {
    const int gw = blockIdx.x * 8 + wv, GW = gridDim.x * 8;
#pragma unroll 1
    for (int it = gw; it < (MROWS / 16) * 44; it += GW) {
      const int tt = it / 44, sub = it % 44;
      const int r0 = tt * 16;
      const bool pr = r0 < NPR;
      const int t0 = pr ? (r0 % LP) : 0;
      const int s0 = r0 - NPR;
    if (sub < 24) {
      const int vec = sub % 12, hf = sub / 12, ib = hf * 8;
      const int cc = vec * 128 + lane * 2;
      const float2 wv0 = *(const float2*)(conv_a + 0 * 1536 + cc), wv1 = *(const float2*)(conv_a + 1 * 1536 + cc);
      const float2 wv2 = *(const float2*)(conv_a + 2 * 1536 + cc), wv3 = *(const float2*)(conv_a + 3 * 1536 + cc);
#define CONV_OUT(i_, x0, x1, x2, x3) do { \
        float y0 = wv3.x * (x0).x + wv2.x * (x1).x + wv1.x * (x2).x + wv0.x * (x3).x; \
        float y1 = wv3.y * (x0).y + wv2.y * (x1).y + wv1.y * (x2).y + wv0.y * (x3).y; \
        y0 = siluf_(y0); y1 = siluf_(y1); \
        if (vec < 8) { const float ss = wave_allsum(y0 * y0 + y1 * y1); float sc = rsqrtf(ss + 1e-6f); \
          if (vec < 4) sc *= 0.08838834764831845f; y0 *= sc; y1 *= sc; } \
        *(float2*)(prep + (size_t)(r0 + (i_)) * PREP_LD + cc) = make_float2(y0, y1); } while (0)
      if (pr) {
        float2 xw[11];
#pragma unroll
        for (int q = 0; q < 11; ++q) {
          const int t = t0 + ib - 3 + q;
          const float* ptr = proj + (size_t)(r0 + ib - 3 + q) * LDP + cc;
          xw[q] = (t >= 0) ? *(const float2*)ptr : make_float2(0.f, 0.f);
        }
#pragma unroll
        for (int ii = 0; ii < 8; ++ii) CONV_OUT(ib + ii, xw[ii + 3], xw[ii + 2], xw[ii + 1], xw[ii]);
      } else {
#pragma unroll 2
        for (int ii = 0; ii < 8; ++ii) {
          const int i = ib + ii;
          const int tl = (s0 + i) & 3, bb = (s0 + i) >> 2;
          const float* cs = cst_a + (size_t)bb * 3 * 1536 + cc;
          const float* pj = proj + (size_t)(r0 + i) * LDP + cc;
          const float2 x0 = *(const float2*)pj;
          const float2 x1 = tl >= 1 ? *(const float2*)(pj - LDP) : *(const float2*)(cs + (2 + tl) * 1536);
          const float2 x2 = tl >= 2 ? *(const float2*)(pj - 2 * LDP) : *(const float2*)(cs + (1 + tl) * 1536);
          const float2 x3 = tl >= 3 ? *(const float2*)(pj - 3 * LDP) : *(const float2*)(cs + (0 + tl) * 1536);
          CONV_OUT(i, x0, x1, x2, x3);
        }
      }
#undef CONV_OUT
    }
    else if (sub < 28) {
      const int cq = sub - 24, ch = cq * 64 + lane;
      float rcv[4];
#pragma unroll
      for (int m = 0; m < 4; ++m) rcv[m] = proj[(size_t)(r0 + (lane >> 4) + 4 * m) * LDP + C_RC + (lane & 15)];
      float w2v[16];
#pragma unroll
      for (int jj = 0; jj < 16; ++jj) w2v[jj] = w2[jj * 256 + ch];
      const float b2v = b2[ch];
      float qv[16], kv[16];
#pragma unroll
      for (int i = 0; i < 16; ++i) { qv[i] = proj[(size_t)(r0 + i) * LDP + C_QC + ch]; kv[i] = proj[(size_t)(r0 + i) * LDP + C_KC + ch]; }
      float P = 1.f;
#pragma unroll
      for (int i = 0; i < 16; ++i) {
        float z = b2v;
#pragma unroll
        for (int jj = 0; jj < 16; ++jj)
          z += __builtin_bit_cast(float, __builtin_amdgcn_readlane(__builtin_bit_cast(int, rcv[i >> 2]), (i & 3) * 16 + jj)) * w2v[jj];
        const float al = __expf(-softplusf_(-z) * (1.f / 16.f));
        float* pp = prep + (size_t)(r0 + i) * PREP_LD;
        if (pr) { P *= al; pp[P_QC + ch] = qv[i] * 0.125f * P; pp[P_KC + ch] = kv[i] * __builtin_amdgcn_rcpf(P); }
        else { pp[P_QC + ch] = qv[i] * 0.125f; pp[P_KC + ch] = kv[i]; pp[P_AC + ch] = al; }
      }
      if (pr) ((float*)(p.ws + WS_GDEC))[(size_t)tt * 256 + ch] = P;
    } else {
      const int i = sub - 28;
      const int pos = pr ? (t0 + i) : (16384 + ((s0 + i) & 3));
      const float* pr_ = proj + (size_t)(r0 + i) * LDP;
      float* pp = prep + (size_t)(r0 + i) * PREP_LD;
      const int f = lane & 31, hb = lane >> 5;
      const float freq = exp2f(-(float)f * (13.287712379549449f / 32.f));
      const float ang = (float)pos * freq;
      double rev = (double)ang * 0.15915494309189535;
      rev -= floor(rev);
      const float fr_ = (float)rev;
      const float cs = __builtin_amdgcn_cosf(fr_), sn = __builtin_amdgcn_sinf(fr_);
#pragma unroll
      for (int m = 0; m < 2; ++m) {
        const int hh = hb + 2 * m;
        float gq = 1.f, gk = 0.125f;
        if (pr) { const float lgam = log2f(1.f - exp2f(-5.f - (float)hh)); gq = exp2f((float)(i + 1) * lgam); gk = 0.125f * exp2f(-(float)(i + 1) * lgam); }
        const float q1 = pr_[C_QD + hh * 64 + f] * gq, q2 = pr_[C_QD + hh * 64 + 32 + f] * gq;
        const float k1 = pr_[C_KD + hh * 64 + f] * gk, k2 = pr_[C_KD + hh * 64 + 32 + f] * gk;
        pp[P_QD + hh * 64 + f] = q1 * cs - q2 * sn;
        pp[P_QD + hh * 64 + 32 + f] = q2 * cs + q1 * sn;
        pp[P_KD + hh * 64 + f] = k1 * cs - k2 * sn;
        pp[P_KD + hh * 64 + 32 + f] = k2 * cs + k1 * sn;
      }
    }
    }
  }
  const size_t gtid = (size_t)blockIdx.x * NTHR + tid, gsz = (size_t)gridDim.x * NTHR;
  for (size_t idx = gtid; idx < (size_t)132 * 3 * 2048; idx += gsz) {
    const int c = (int)(idx & 2047), jj = (int)((idx >> 11) % 3), bb = (int)(idx / (2048 * 3));
    const size_t row = bb < 4 ? (size_t)(bb * LP + LP - 3 + jj) : (size_t)(NPR + (bb - 4) * 4 + 1 + jj);
    if (c < 1536) {
      const float v = proj[row * LDP + c];
      if (bb < 4) p.out[O_PDC + ((size_t)(l * 4 + bb) * 3 + jj) * 1536 + c] = v;
      else p.out[O_SDC + ((size_t)(l * 128 + bb - 4) * 3 + jj) * 1536 + c] = v;
    } else {
      const int c2 = c - 1536;
      const float v = proj[row * LDP + C_XB + c2];
      if (bb < 4) p.out[O_PLC + ((size_t)(l * 4 + bb) * 3 + jj) * 512 + c2] = v;
      else p.out[O_SLC + ((size_t)(l * 128 + bb - 4) * 3 + jj) * 512 + c2] = v;
    }
  }
}

using f2 = __attribute__((ext_vector_type(2))) float;
constexpr int NST = LP / 16;

template <int MODE>
__device__ __forceinline__ void scan_prompt_half(CP& p, int l, int bh, int cg, float* sm, int rt) {
  constexpr int DK = MODE == 0 ? 128 : 64;
  constexpr int EPL = DK / 16, E2 = EPL / 2;
  constexpr int QOFF = MODE == 0 ? P_QA : (MODE == 1 ? P_QC : P_QD);
  constexpr int KOFF = MODE == 0 ? P_KA : (MODE == 1 ? P_KC : P_KD);
  constexpr int OB = MODE == 0 ? 0 : (MODE == 1 ? 1024 : 1536);
  constexpr int BUFSZ = 48 * DK + 256 + 32;
  const int lane = rt & 63, wl = rt >> 6;
  const int b = bh >> 2, h = bh & 3;
  const int j = lane & 15, cl = wl * 4 + (lane >> 4);
  const float* prep = (const float*)(p.ws + WS_PREP) + (size_t)(b * LP) * PREP_LD;
  const float* proj = (const float*)(p.ws + WS_PROJ) + (size_t)(b * LP) * LDP;
  float* obuf = (float*)(p.ws + WS_OBUF) + (size_t)(b * LP) * 2048;
  f2 s[E2];
#pragma unroll
  for (int e = 0; e < E2; ++e) s[e] = (f2){0.f, 0.f};
  const float gamma = 1.f - exp2f(-5.f - (float)h);
  const int lt0 = rt / (DK / 4), lc0 = (rt % (DK / 4)) * 4;
  const int lt1 = (rt + 256) / (DK / 4);
  const bool ld_v = rt < 64;
  const int vt = rt >> 2, vc = (rt & 3) * 4;
  float4 rq0_0 = make_float4(0, 0, 0, 0), rq1_0 = rq0_0, rk0_0 = rq0_0, rk1_0 = rq0_0, ral_0 = rq0_0, rv_0 = rq0_0; float rsc_0 = 0.f;
  float4 rq0_1 = rq0_0, rq1_1 = rq0_0, rk0_1 = rq0_0, rk1_1 = rq0_0, ral_1 = rq0_0, rv_1 = rq0_0; float rsc_1 = 0.f;
#define GLOAD(st_, S) do { const int t0_ = (st_) * 16; \
    { const float* rp_ = prep + (size_t)(t0_ + lt0) * PREP_LD; rq0_##S = *(const float4*)(rp_ + QOFF + h * DK + lc0); \
      rk0_##S = *(const float4*)(rp_ + KOFF + h * DK + lc0); if (MODE == 1) ral_##S = *(const float4*)(rp_ + P_AC + h * 64 + lc0); } \
    if (MODE == 0) { const float* rp_ = prep + (size_t)(t0_ + lt1) * PREP_LD; rq1_##S = *(const float4*)(rp_ + QOFF + h * DK + lc0); \
      rk1_##S = *(const float4*)(rp_ + KOFF + h * DK + lc0); } \
    if (ld_v) { if (MODE == 0) rv_##S = *(const float4*)(prep + (size_t)(t0_ + vt) * PREP_LD + P_VA + h * 128 + cg * 16 + vc); \
      else rv_##S = *(const float4*)(proj + (size_t)(t0_ + vt) * LDP + (MODE == 1 ? C_VC : C_VD) + h * 128 + cg * 16 + vc); } \
    if (MODE == 0 && rt < 32) rsc_##S = prep[(size_t)(t0_ + (rt & 15)) * PREP_LD + (rt < 16 ? P_AB : P_AB + 4) + h]; } while (0)
#define LSTORE(bf_, S) do { *(float4*)((bf_) + lt0 * DK + lc0) = rq0_##S; *(float4*)((bf_) + 16 * DK + lt0 * DK + lc0) = rk0_##S; \
    if (MODE == 1) *(float4*)((bf_) + 32 * DK + lt0 * DK + lc0) = ral_##S; \
    if (MODE == 0) { *(float4*)((bf_) + lt1 * DK + lc0) = rq1_##S; *(float4*)((bf_) + 16 * DK + lt1 * DK + lc0) = rk1_##S; } \
    if (ld_v) *(float4*)((bf_) + 48 * DK + vt * 16 + vc) = rv_##S; \
    if (MODE == 0 && rt < 32) (bf_)[48 * DK + 256 + rt] = rsc_##S; } while (0)
  GLOAD(0, 0);
  LSTORE(sm, 0);
  GLOAD(1, 1);
  __syncthreads();
  auto stage = [&](const int st, const int SL) __attribute__((always_inline)) {
    const float* bf = sm + (st & 1) * BUFSZ;
    float* bn = sm + ((st + 1) & 1) * BUFSZ;
    if (st + 2 < NST) { if (SL == 0) GLOAD(st + 2, 0); else GLOAD(st + 2, 1); }
    float okeep = 0.f;
    f2 kkb[3][E2], qqb[3][E2]; float vvb[3], aab[3], beb[3]; float4 alb[3];
#define LOADTOK(ti_, S_) do { \
      _Pragma("unroll") for (int e4 = 0; e4 < EPL / 4; ++e4) { \
        const float4 k4 = *(const float4*)(bf + 16 * DK + (ti_) * DK + j * EPL + e4 * 4); \
        const float4 q4 = *(const float4*)(bf + (ti_) * DK + j * EPL + e4 * 4); \
        kkb[S_][e4 * 2 + 0] = (f2){k4.x, k4.y}; kkb[S_][e4 * 2 + 1] = (f2){k4.z, k4.w}; \
        qqb[S_][e4 * 2 + 0] = (f2){q4.x, q4.y}; qqb[S_][e4 * 2 + 1] = (f2){q4.z, q4.w}; } \
      vvb[S_] = bf[48 * DK + (ti_) * 16 + cl]; \
      if (MODE == 0) { aab[S_] = bf[48 * DK + 256 + (ti_)]; beb[S_] = bf[48 * DK + 256 + 16 + (ti_)]; } \
      if (MODE == 1) alb[S_] = *(const float4*)(bf + 32 * DK + (ti_) * DK + j * EPL); } while (0)
    LOADTOK(0, 0);
    LOADTOK(1, 1);
#pragma unroll
    for (int ti = 0; ti < 16; ++ti) {
      constexpr int dummy_ = 0; (void)dummy_;
      const int cs = ti % 3;
      if (ti + 2 < 16) { LOADTOK(ti + 2, (ti + 2) % 3); }
      __builtin_amdgcn_sched_barrier(0);
      f2 kk[E2], qq[E2];
#pragma unroll
      for (int e = 0; e < E2; ++e) { kk[e] = kkb[cs][e]; qq[e] = qqb[cs][e]; }
      const float vv = vvb[cs];
      if (MODE == 0) {
        f2 ra = kk[0] * s[0];
#pragma unroll
        for (int e = 1; e < E2; ++e) ra = kk[e] * s[e] + ra;
        const float r = row16_allsum(ra.x + ra.y);
        const float a = aab[cs], be = beb[cs];
        const float dd = be * (vv - a * r);
        const f2 a2 = (f2){a, a}, d2 = (f2){dd, dd};
#pragma unroll
        for (int e = 0; e < E2; ++e) s[e] = kk[e] * d2 + a2 * s[e];
      } else if (MODE == 1) {
        const float4 a4 = alb[cs];
        const f2 v2 = (f2){vv, vv};
        s[0] = kk[0] * v2 + ((f2){a4.x, a4.y}) * s[0];
        s[1] = kk[1] * v2 + ((f2){a4.z, a4.w}) * s[1];
      } else {
        const f2 v2 = (f2){vv, vv}, g2 = (f2){gamma, gamma};
#pragma unroll
        for (int e = 0; e < E2; ++e) s[e] = kk[e] * v2 + g2 * s[e];
      }
      f2 oa = qq[0] * s[0];
#pragma unroll
      for (int e = 1; e < E2; ++e) oa = qq[e] * s[e] + oa;
      const float o = row16_allsum(oa.x + oa.y);
      if (j == ti) okeep = o;
    }
#undef LOADTOK
    if (st + 1 < NST) { if (SL == 0) LSTORE(bn, 1); else LSTORE(bn, 0); }
    obuf[(size_t)(st * 16 + j) * 2048 + OB + h * 128 + cg * 16 + cl] = okeep;
    __syncthreads();
    };
#pragma unroll 1
  for (int st = 0; st + 1 < NST; st += 2) { stage(st, 0); stage(st + 1, 1); }
  stage(NST - 1, 0);
#undef GLOAD
#undef LSTORE
  float* so = p.out + (MODE == 0 ? O_PD : (MODE == 1 ? O_PG : O_PR)) + ((size_t)(l * 4 + b) * 4 + h) * DK * 128;
#pragma unroll
  for (int e = 0; e < E2; ++e) {
    so[(size_t)(j * EPL + 2 * e) * 128 + cg * 16 + cl] = s[e].x;
    so[(size_t)(j * EPL + 2 * e + 1) * 128 + cg * 16 + cl] = s[e].y;
  }
}

__device__ __forceinline__ void phase_prep2(CP& p, int wv) {
  extern __shared__ __attribute__((aligned(16))) unsigned char smem_raw[];
  const int tid = opaque_tid(wv), hd = tid >> 7, d = tid & 127;
  float* hs = (float*)smem_raw + hd * 4864;
  float* kS = hs; float* vS = hs + 2112; float* AS = hs + 4224; float* TS = hs + 4496; float* lgS = hs + 4768; float* gcS = hs + 4784; float* beS = hs + 4800;
  float* prep = (float*)(p.ws + WS_PREP);
#pragma unroll 1
  for (int tile = blockIdx.x; tile < 4 * NST; tile += gridDim.x) {
    const int r0 = tile * 16;
#pragma unroll
    for (int i = 0; i < 16; ++i) {
      kS[i * 132 + d] = prep[(size_t)(r0 + i) * PREP_LD + P_KA + hd * 128 + d];
      vS[i * 132 + d] = prep[(size_t)(r0 + i) * PREP_LD + P_VA + hd * 128 + d];
    }
    if (d < 16) { lgS[d] = logf(prep[(size_t)(r0 + d) * PREP_LD + P_AB + hd]); beS[d] = prep[(size_t)(r0 + d) * PREP_LD + P_AB + 4 + hd]; }
    __syncthreads();
    if (d < 16) { float g = 0.f; for (int m = 0; m <= d; ++m) g += lgS[m]; gcS[d] = g; }
    float dots[2];
#pragma unroll
    for (int e2 = 0; e2 < 2; ++e2) {
      const int e = d + 128 * e2, i = e >> 4, m = e & 15;
      float acc = 0.f;
      if (m < i) {
        const float4* ki = (const float4*)(kS + i * 132); const float4* km = (const float4*)(kS + m * 132);
#pragma unroll 8
        for (int c = 0; c < 32; ++c) { const float4 x = ki[c], y = km[c]; acc += x.x * y.x + x.y * y.y + x.z * y.z + x.w * y.w; }
      }
      dots[e2] = acc;
    }
    __syncthreads();
#pragma unroll
    for (int e2 = 0; e2 < 2; ++e2) {
      const int e = d + 128 * e2, i = e >> 4, m = e & 15;
      AS[i * 17 + m] = (m < i) ? beS[i] * dots[e2] * __expf(gcS[i] - gcS[m]) : 0.f;
    }
    __syncthreads();
    if (d < 16) {
      float tcol[16];
#pragma unroll
      for (int i = 0; i < 16; ++i) {
        float t = (i == d) ? 1.f : 0.f;
#pragma unroll
        for (int m = 0; m < i; ++m) t -= AS[i * 17 + m] * tcol[m];
        tcol[i] = t;
      }
#pragma unroll
      for (int i = 0; i < 16; ++i) TS[i * 17 + d] = tcol[i];
    }
    __syncthreads();
    {
      float xk[16], xv[16];
#pragma unroll
      for (int m = 0; m < 16; ++m) { const float bm = beS[m]; xk[m] = bm * __expf(gcS[m]) * kS[m * 132 + d]; xv[m] = bm * vS[m * 132 + d]; }
      const float g15 = gcS[15];
#pragma unroll
      for (int i = 0; i < 16; ++i) {
        float W = 0.f, U = 0.f;
#pragma unroll
        for (int m = 0; m <= i; ++m) { const float t = TS[i * 17 + m]; W += t * xk[m]; U += t * xv[m]; }
        float* pp = prep + (size_t)(r0 + i) * PREP_LD;
        pp[P_WA + hd * 128 + d] = W;
        pp[P_VA + hd * 128 + d] = U;
        pp[P_KH + hd * 128 + d] = kS[i * 132 + d] * __expf(g15 - gcS[i]);
      }
      if (d < 16) prep[(size_t)(r0 + d) * PREP_LD + P_GC + hd] = __expf(gcS[d]);
#pragma unroll
      for (int e2 = 0; e2 < 2; ++e2) {
        const int e = d + 128 * e2, i = e >> 4, m = e & 15;
        prep[(size_t)(r0 + i) * PREP_LD + P_DM + hd * 16 + m] = (m <= i) ? __expf(gcS[i] - gcS[m]) : 0.f;
      }
    }
    __syncthreads();
  }
}

__device__ __forceinline__ void scan_prompt_delta_mfma(CP& p, int l, int bh, int half, float* sm, int rt) {
  constexpr int BUFSZ = 10464;
  const int lane = rt & 63, wl = rt >> 6, n = lane & 15, q = lane >> 4;
  const int b = bh >> 2, h = bh & 3;
  const int col0 = half * 64 + wl * 16;
  const float* prep = (const float*)(p.ws + WS_PREP) + (size_t)(b * LP) * PREP_LD;
  float* obuf = (float*)(p.ws + WS_OBUF) + (size_t)(b * LP) * 2048 + h * 128 + col0 + n;
  f32x4 St[8];
#pragma unroll
  for (int kt = 0; kt < 8; ++kt) St[kt] = (f32x4){0.f, 0.f, 0.f, 0.f};
  const int lt0 = rt >> 5, lt1 = lt0 + 8, lc = (rt & 31) * 4;
  const int tt_ = rt & 15, tc = (rt >> 4) * 4;
  float4 rq0_0, rq1_0, rk0_0, rk1_0, rw0_0, rw1_0, rh0_0, rh1_0, ru_0, rd_0 = make_float4(0, 0, 0, 0); float rg_0 = 0.f;
  float4 rq0_1, rq1_1, rk0_1, rk1_1, rw0_1, rw1_1, rh0_1, rh1_1, ru_1, rd_1 = make_float4(0, 0, 0, 0); float rg_1 = 0.f;
  rq0_0 = rq1_0 = rk0_0 = rk1_0 = rw0_0 = rw1_0 = rh0_0 = rh1_0 = ru_0 = make_float4(0, 0, 0, 0);
  rq0_1 = rq1_1 = rk0_1 = rk1_1 = rw0_1 = rw1_1 = rh0_1 = rh1_1 = ru_1 = make_float4(0, 0, 0, 0);
#define GLOADD(st_, S) do { const float* ra_ = prep + (size_t)((st_) * 16 + lt0) * PREP_LD + h * 128 + lc; \
    const float* rb_ = prep + (size_t)((st_) * 16 + lt1) * PREP_LD + h * 128 + lc; \
    rq0_##S = *(const float4*)(ra_ + P_QA); rq1_##S = *(const float4*)(rb_ + P_QA); rk0_##S = *(const float4*)(ra_ + P_KA); rk1_##S = *(const float4*)(rb_ + P_KA); \
    rw0_##S = *(const float4*)(ra_ + P_WA); rw1_##S = *(const float4*)(rb_ + P_WA); \
    const float* rt__ = prep + (size_t)((st_) * 16 + tt_) * PREP_LD + h * 128; \
    rh0_##S = *(const float4*)(rt__ + P_KH + tc); rh1_##S = *(const float4*)(rt__ + P_KH + 64 + tc); \
    ru_##S = *(const float4*)(rt__ + P_VA + half * 64 + tc); \
    if (rt < 16) rg_##S = prep[(size_t)((st_) * 16 + rt) * PREP_LD + P_GC + h]; \
    if (rt < 64) rd_##S = *(const float4*)(prep + (size_t)((st_) * 16 + (rt >> 2)) * PREP_LD + P_DM + h * 16 + (rt & 3) * 4); } while (0)
#define LSTORED(bf_, S) do { *(float4*)((bf_) + lt0 * 132 + lc) = rq0_##S; *(float4*)((bf_) + lt1 * 132 + lc) = rq1_##S; \
    *(float4*)((bf_) + 2112 + lt0 * 132 + lc) = rk0_##S; *(float4*)((bf_) + 2112 + lt1 * 132 + lc) = rk1_##S; \
    *(float4*)((bf_) + 4224 + lt0 * 132 + lc) = rw0_##S; *(float4*)((bf_) + 4224 + lt1 * 132 + lc) = rw1_##S; \
    (bf_)[6336 + (tc + 0) * 20 + tt_] = rh0_##S.x; (bf_)[6336 + (tc + 1) * 20 + tt_] = rh0_##S.y; (bf_)[6336 + (tc + 2) * 20 + tt_] = rh0_##S.z; (bf_)[6336 + (tc + 3) * 20 + tt_] = rh0_##S.w; \
    (bf_)[6336 + (tc + 64) * 20 + tt_] = rh1_##S.x; (bf_)[6336 + (tc + 65) * 20 + tt_] = rh1_##S.y; (bf_)[6336 + (tc + 66) * 20 + tt_] = rh1_##S.z; (bf_)[6336 + (tc + 67) * 20 + tt_] = rh1_##S.w; \
    (bf_)[8896 + (tc + 0) * 20 + tt_] = ru_##S.x; (bf_)[8896 + (tc + 1) * 20 + tt_] = ru_##S.y; (bf_)[8896 + (tc + 2) * 20 + tt_] = ru_##S.z; (bf_)[8896 + (tc + 3) * 20 + tt_] = ru_##S.w; \
    if (rt < 16) (bf_)[10176 + rt] = rg_##S; \
    if (rt < 64) *(float4*)((bf_) + 10208 + rt * 4) = rd_##S; } while (0)
  GLOADD(0, 0);
  LSTORED(sm, 0);
  GLOADD(1, 1);
  __syncthreads();
  auto stage = [&](const int st, const int SL) __attribute__((always_inline)) {
    const float* bf = sm + (st & 1) * BUFSZ;
    float* bn = sm + ((st + 1) & 1) * BUFSZ;
    if (st + 2 < NST) { if (SL == 0) GLOADD(st + 2, 0); else GLOADD(st + 2, 1); }
    const float4 egm = *(const float4*)(bf + 10176 + 4 * q);
    const float4 dm4 = *(const float4*)(bf + 10208 + n * 16 + 4 * q);
    const float e15 = bf[10176 + 15];
    f32x4 ws = (f32x4){0.f, 0.f, 0.f, 0.f}, qs = ws, pt = ws;
#pragma unroll
    for (int ks = 0; ks < 4; ++ks) {
      const int o0 = n * 132 + 32 * ks + 4 * q;
      const float4 qa = *(const float4*)(bf + o0), qb = *(const float4*)(bf + o0 + 16);
      const float4 ka = *(const float4*)(bf + 2112 + o0), kb = *(const float4*)(bf + 2112 + o0 + 16);
      const float4 wa = *(const float4*)(bf + 4224 + o0), wb = *(const float4*)(bf + 4224 + o0 + 16);
      const bf16x8 QF = mkfrag(cvtpk(qa.x, qa.y), cvtpk(qa.z, qa.w), cvtpk(qb.x, qb.y), cvtpk(qb.z, qb.w));
      const bf16x8 KF = mkfrag(cvtpk(ka.x, ka.y), cvtpk(ka.z, ka.w), cvtpk(kb.x, kb.y), cvtpk(kb.z, kb.w));
      const bf16x8 WF = mkfrag(cvtpk(wa.x, wa.y), cvtpk(wa.z, wa.w), cvtpk(wb.x, wb.y), cvtpk(wb.z, wb.w));
      const bf16x8 SB = mkfrag(cvtpk(St[2 * ks][0], St[2 * ks][1]), cvtpk(St[2 * ks][2], St[2 * ks][3]),
                               cvtpk(St[2 * ks + 1][0], St[2 * ks + 1][1]), cvtpk(St[2 * ks + 1][2], St[2 * ks + 1][3]));
      ws = __builtin_amdgcn_mfma_f32_16x16x32_bf16(WF, SB, ws, 0, 0, 0);
      qs = __builtin_amdgcn_mfma_f32_16x16x32_bf16(QF, SB, qs, 0, 0, 0);
      pt = __builtin_amdgcn_mfma_f32_16x16x32_bf16(KF, QF, pt, 0, 0, 0);
    }
    const float4 u4 = *(const float4*)(bf + 8896 + (wl * 16 + n) * 20 + 4 * q);
    const float vn0 = u4.x - ws[0], vn1 = u4.y - ws[1], vn2 = u4.z - ws[2], vn3 = u4.w - ws[3];
    const bf16x8 VNF = mkfrag(cvtpk(vn0, vn1), cvtpk(vn2, vn3), 0u, 0u);
    const float p0 = pt[0] * dm4.x, p1 = pt[1] * dm4.y, p2 = pt[2] * dm4.z, p3 = pt[3] * dm4.w;
    const bf16x8 PF = mkfrag(cvtpk(p0, p1), cvtpk(p2, p3), 0u, 0u);
    f32x4 qsc;
    qsc[0] = qs[0] * egm.x; qsc[1] = qs[1] * egm.y; qsc[2] = qs[2] * egm.z; qsc[3] = qs[3] * egm.w;
    const f32x4 o = __builtin_amdgcn_mfma_f32_16x16x32_bf16(PF, VNF, qsc, 0, 0, 0);
#pragma unroll
    for (int r = 0; r < 4; ++r) obuf[(size_t)(st * 16 + 4 * q + r) * 2048] = o[r];
#pragma unroll
    for (int kt = 0; kt < 8; ++kt) {
      const float4 k4 = *(const float4*)(bf + 6336 + (16 * kt + n) * 20 + 4 * q);
      const bf16x8 KTF = mkfrag(cvtpk(k4.x, k4.y), cvtpk(k4.z, k4.w), 0u, 0u);
      f32x4 sc;
      sc[0] = St[kt][0] * e15; sc[1] = St[kt][1] * e15; sc[2] = St[kt][2] * e15; sc[3] = St[kt][3] * e15;
      St[kt] = __builtin_amdgcn_mfma_f32_16x16x32_bf16(KTF, VNF, sc, 0, 0, 0);
    }
    if (st + 1 < NST) { if (SL == 0) LSTORED(bn, 1); else LSTORED(bn, 0); }
    __syncthreads();
    };
#pragma unroll 1
  for (int st = 0; st + 1 < NST; st += 2) { stage(st, 0); stage(st + 1, 1); }
  stage(NST - 1, 0);
#undef GLOADD
#undef LSTORED
  float* so = p.out + O_PD + ((size_t)(l * 4 + b) * 4 + h) * 128 * 128 + col0 + n;
#pragma unroll
  for (int kt = 0; kt < 8; ++kt)
#pragma unroll
    for (int r = 0; r < 4; ++r) so[(size_t)(16 * kt + 4 * q + r) * 128] = St[kt][r];
}

template <int MODE>
__device__ __forceinline__ void scan_prompt_mfma(CP& p, int l, int bh, int half, float* sm, int rt) {
  constexpr int QOFF = MODE == 1 ? P_QC : P_QD, KOFF = MODE == 1 ? P_KC : P_KD, OB = MODE == 1 ? 1024 : 1536;
  constexpr int BUFSZ = 4800;
  const int lane = rt & 63, wl = rt >> 6, n = lane & 15, q = lane >> 4;
  const int b = bh >> 2, h = bh & 3;
  const int col0 = half * 64 + wl * 16;
  const float* prep = (const float*)(p.ws + WS_PREP) + (size_t)(b * LP) * PREP_LD + h * 64;
  const float* proj = (const float*)(p.ws + WS_PROJ) + (size_t)(b * LP) * LDP + (MODE == 1 ? C_VC : C_VD) + h * 128 + half * 64;
  float* obuf = (float*)(p.ws + WS_OBUF) + (size_t)(b * LP) * 2048 + OB + h * 128 + col0 + n;
  const float* gdec = (const float*)(p.ws + WS_GDEC) + (size_t)(b * NST) * 256 + h * 64;
  f32x4 St[4];
#pragma unroll
  for (int kt = 0; kt < 4; ++kt) St[kt] = (f32x4){0.f, 0.f, 0.f, 0.f};
  float g16 = 1.f - exp2f(-5.f - (float)h);
  g16 *= g16; g16 *= g16; g16 *= g16; g16 *= g16;
  const int lt = rt >> 4, lc = (rt & 15) * 4;
  const int tt_ = rt & 15, tc = (rt >> 4) * 4;
  float4 rq_0 = make_float4(0, 0, 0, 0), rk_0 = rq_0, rv_0 = rq_0, rp_0 = rq_0, rx_0 = rq_0, rq_1 = rq_0, rk_1 = rq_0, rv_1 = rq_0, rp_1 = rq_0, rx_1 = rq_0;
#define GLOADM(st_, S) do { const float* rp__ = prep + (size_t)((st_) * 16 + lt) * PREP_LD; \
    rq_##S = *(const float4*)(rp__ + QOFF + lc); rk_##S = *(const float4*)(rp__ + KOFF + lc); \
    rx_##S = *(const float4*)(prep + (size_t)((st_) * 16 + tt_) * PREP_LD + KOFF + tc); \
    rv_##S = *(const float4*)(proj + (size_t)((st_) * 16 + tt_) * LDP + tc); \
    if (MODE == 1 && rt < 16) rp_##S = *(const float4*)(gdec + (size_t)(st_) * 256 + rt * 4); } while (0)
#define LSTOREM(bf_, S) do { *(float4*)((bf_) + lt * 68 + lc) = rq_##S; *(float4*)((bf_) + 1088 + lt * 68 + lc) = rk_##S; \
    (bf_)[2176 + (tc + 0) * 20 + tt_] = rx_##S.x; (bf_)[2176 + (tc + 1) * 20 + tt_] = rx_##S.y; \
    (bf_)[2176 + (tc + 2) * 20 + tt_] = rx_##S.z; (bf_)[2176 + (tc + 3) * 20 + tt_] = rx_##S.w; \
    (bf_)[3456 + (tc + 0) * 20 + tt_] = rv_##S.x; (bf_)[3456 + (tc + 1) * 20 + tt_] = rv_##S.y; \
    (bf_)[3456 + (tc + 2) * 20 + tt_] = rv_##S.z; (bf_)[3456 + (tc + 3) * 20 + tt_] = rv_##S.w; \
    if (MODE == 1 && rt < 16) *(float4*)((bf_) + 4736 + rt * 4) = rp_##S; } while (0)
  GLOADM(0, 0);
  LSTOREM(sm, 0);
  GLOADM(1, 1);
  __syncthreads();
  auto stage = [&](const int st, const int SL) __attribute__((always_inline)) {
    const float* bf = sm + (st & 1) * BUFSZ;
    float* bn = sm + ((st + 1) & 1) * BUFSZ;
    if (st + 2 < NST) { if (SL == 0) GLOADM(st + 2, 0); else GLOADM(st + 2, 1); }
    bf16x8 QF[2], KF[2], SB[2];
#pragma unroll
    for (int ks = 0; ks < 2; ++ks) {
      const float4 qa = *(const float4*)(bf + n * 68 + 32 * ks + 4 * q), qb = *(const float4*)(bf + n * 68 + 32 * ks + 16 + 4 * q);
      const float4 ka = *(const float4*)(bf + 1088 + n * 68 + 32 * ks + 4 * q), kb = *(const float4*)(bf + 1088 + n * 68 + 32 * ks + 16 + 4 * q);
      QF[ks] = mkfrag(cvtpk(qa.x, qa.y), cvtpk(qa.z, qa.w), cvtpk(qb.x, qb.y), cvtpk(qb.z, qb.w));
      KF[ks] = mkfrag(cvtpk(ka.x, ka.y), cvtpk(ka.z, ka.w), cvtpk(kb.x, kb.y), cvtpk(kb.z, kb.w));
      SB[ks] = mkfrag(cvtpk(St[2 * ks][0], St[2 * ks][1]), cvtpk(St[2 * ks][2], St[2 * ks][3]),
                      cvtpk(St[2 * ks + 1][0], St[2 * ks + 1][1]), cvtpk(St[2 * ks + 1][2], St[2 * ks + 1][3]));
    }
    f32x4 qs = (f32x4){0.f, 0.f, 0.f, 0.f}, pt = qs;
    qs = __builtin_amdgcn_mfma_f32_16x16x32_bf16(QF[0], SB[0], qs, 0, 0, 0);
    qs = __builtin_amdgcn_mfma_f32_16x16x32_bf16(QF[1], SB[1], qs, 0, 0, 0);
    pt = __builtin_amdgcn_mfma_f32_16x16x32_bf16(KF[0], QF[0], pt, 0, 0, 0);
    pt = __builtin_amdgcn_mfma_f32_16x16x32_bf16(KF[1], QF[1], pt, 0, 0, 0);
#pragma unroll
    for (int r = 0; r < 4; ++r) if (4 * q + r > n) pt[r] = 0.f;
    const bf16x8 PF = mkfrag(cvtpk(pt[0], pt[1]), cvtpk(pt[2], pt[3]), 0u, 0u);
    const float4 v4 = *(const float4*)(bf + 3456 + (wl * 16 + n) * 20 + 4 * q);
    const bf16x8 VF = mkfrag(cvtpk(v4.x, v4.y), cvtpk(v4.z, v4.w), 0u, 0u);
    const f32x4 o = __builtin_amdgcn_mfma_f32_16x16x32_bf16(PF, VF, qs, 0, 0, 0);
#pragma unroll
    for (int r = 0; r < 4; ++r) obuf[(size_t)(st * 16 + 4 * q + r) * 2048] = o[r];
#pragma unroll
    for (int kt = 0; kt < 4; ++kt) {
      const float4 k4 = *(const float4*)(bf + 2176 + (16 * kt + n) * 20 + 4 * q);
      const bf16x8 KTF = mkfrag(cvtpk(k4.x, k4.y), cvtpk(k4.z, k4.w), 0u, 0u);
      St[kt] = __builtin_amdgcn_mfma_f32_16x16x32_bf16(KTF, VF, St[kt], 0, 0, 0);
      if (MODE == 1) {
        const float4 p4 = *(const float4*)(bf + 4736 + 16 * kt + 4 * q);
        St[kt][0] *= p4.x; St[kt][1] *= p4.y; St[kt][2] *= p4.z; St[kt][3] *= p4.w;
      } else {
        St[kt][0] *= g16; St[kt][1] *= g16; St[kt][2] *= g16; St[kt][3] *= g16;
      }
    }
    if (st + 1 < NST) { if (SL == 0) LSTOREM(bn, 1); else LSTOREM(bn, 0); }
    __syncthreads();
  };
#pragma unroll 1
  for (int st = 0; st + 1 < NST; st += 2) { stage(st, 0); stage(st + 1, 1); }
  stage(NST - 1, 0);
#undef GLOADM
#undef LSTOREM
  float* so = p.out + (MODE == 1 ? O_PG : O_PR) + ((size_t)(l * 4 + b) * 4 + h) * 64 * 128 + col0 + n;
#pragma unroll
  for (int kt = 0; kt < 4; ++kt)
#pragma unroll
    for (int r = 0; r < 4; ++r) so[(size_t)(16 * kt + 4 * q + r) * 128] = St[kt][r];
}

template <int MODE>
__device__ __forceinline__ void scan_sample(CP& p, int l, int item, int wv) {
  extern __shared__ __attribute__((aligned(16))) unsigned char smem_raw[];
  constexpr int DK = MODE == 0 ? 128 : 64;
  constexpr int NP = MODE == 0 ? 2 : 1;
  constexpr int RK = DK / NP;
  constexpr int E2 = RK / 2;
  constexpr int TPH = 128 * NP;
  constexpr int QOFF = MODE == 0 ? P_QA : (MODE == 1 ? P_QC : P_QD);
  constexpr int KOFF = MODE == 0 ? P_KA : (MODE == 1 ? P_KC : P_KD);
  constexpr int OB = MODE == 0 ? 0 : (MODE == 1 ? 1024 : 1536);
  const int tid = opaque_tid(wv);
  const int kp = NP == 2 ? (tid & 1) : 0;
  const int col = NP == 2 ? (tid >> 1) : tid;
  const int hl = col >> 7, v = col & 127;
  const int b = NP == 2 ? (item >> 1) : item;
  const int h = NP == 2 ? (item & 1) * 2 + hl : hl;
  const int ht = tid - hl * TPH;
  float* sm = (float*)smem_raw + hl * (12 * DK + 16);
  float* sq = sm; float* sk = sm + 4 * DK; float* sal = sm + 8 * DK; float* ssc = sm + 12 * DK;
  const size_t soff = ((size_t)(l * 128 + b) * 4 + h) * DK * 128 + (size_t)(kp * RK) * 128 + v;
  const float* st_in = (MODE == 0 ? p.in[2] : (MODE == 1 ? p.in[6] : p.in[7])) + soff;
  float* st_out = p.out + (MODE == 0 ? O_SD : (MODE == 1 ? O_SG : O_SR)) + soff;
  const float* prep = (const float*)(p.ws + WS_PREP) + (size_t)(NPR + b * 4) * PREP_LD;
  const float* proj = (const float*)(p.ws + WS_PROJ) + (size_t)(NPR + b * 4) * LDP;
  float* obuf = (float*)(p.ws + WS_OBUF) + (size_t)(NPR + b * 4) * 2048 + OB + h * 128 + v;
  f2 s[E2];
#pragma unroll
  for (int e = 0; e < E2; ++e) { s[e].x = st_in[(size_t)(2 * e) * 128]; s[e].y = st_in[(size_t)(2 * e + 1) * 128]; }
  for (int idx = ht; idx < 4 * DK; idx += TPH) {
    const int t = idx / DK, c = idx % DK;
    sq[idx] = prep[(size_t)t * PREP_LD + QOFF + h * DK + c];
    sk[idx] = prep[(size_t)t * PREP_LD + KOFF + h * DK + c];
    if (MODE == 1) sal[idx] = prep[(size_t)t * PREP_LD + P_AC + h * 64 + c];
  }
  if (MODE == 0 && ht < 8) ssc[ht] = prep[(size_t)(ht & 3) * PREP_LD + (ht < 4 ? P_AB : P_AB + 4) + h];
  float vv[4];
#pragma unroll
  for (int t = 0; t < 4; ++t)
    vv[t] = MODE == 0 ? prep[(size_t)t * PREP_LD + P_VA + h * 128 + v] : proj[(size_t)t * LDP + (MODE == 1 ? C_VC : C_VD) + h * 128 + v];
  const float gamma = 1.f - exp2f(-5.f - (float)h);
  __syncthreads();
#pragma unroll
  for (int t = 0; t < 4; ++t) {
    const float* kt = sk + t * DK + kp * RK; const float* qt = sq + t * DK + kp * RK;
    if (MODE == 0) {
      f2 ra0 = (f2){0.f, 0.f}, ra1 = ra0;
#pragma unroll
      for (int e = 0; e < E2; e += 2) {
        const float4 k4 = *(const float4*)(kt + 2 * e);
        ra0 = ((f2){k4.x, k4.y}) * s[e] + ra0; ra1 = ((f2){k4.z, k4.w}) * s[e + 1] + ra1;
      }
      float r = (ra0.x + ra0.y) + (ra1.x + ra1.y);
      r += dpp_f<0xB1>(r);
      const float a = ssc[t], be = ssc[4 + t];
      const float dd = be * (vv[t] - a * r);
      const f2 a2 = (f2){a, a}, d2 = (f2){dd, dd};
#pragma unroll
      for (int e = 0; e < E2; e += 2) {
        const float4 k4 = *(const float4*)(kt + 2 * e);
        s[e] = ((f2){k4.x, k4.y}) * d2 + a2 * s[e]; s[e + 1] = ((f2){k4.z, k4.w}) * d2 + a2 * s[e + 1];
      }
    } else if (MODE == 1) {
      const f2 v2 = (f2){vv[t], vv[t]};
#pragma unroll
      for (int e = 0; e < E2; e += 2) {
        const float4 k4 = *(const float4*)(kt + 2 * e);
        const float4 a4 = *(const float4*)(sal + t * DK + 2 * e);
        s[e] = ((f2){k4.x, k4.y}) * v2 + ((f2){a4.x, a4.y}) * s[e]; s[e + 1] = ((f2){k4.z, k4.w}) * v2 + ((f2){a4.z, a4.w}) * s[e + 1];
      }
    } else {
      const f2 v2 = (f2){vv[t], vv[t]}, g2 = (f2){gamma, gamma};
#pragma unroll
      for (int e = 0; e < E2; e += 2) {
        const float4 k4 = *(const float4*)(kt + 2 * e);
        s[e] = ((f2){k4.x, k4.y}) * v2 + g2 * s[e]; s[e + 1] = ((f2){k4.z, k4.w}) * v2 + g2 * s[e + 1];
      }
    }
    f2 oa0 = (f2){0.f, 0.f}, oa1 = oa0;
#pragma unroll
    for (int e = 0; e < E2; e += 2) {
      const float4 q4 = *(const float4*)(qt + 2 * e);
      oa0 = ((f2){q4.x, q4.y}) * s[e] + oa0; oa1 = ((f2){q4.z, q4.w}) * s[e + 1] + oa1;
    }
    float o = (oa0.x + oa0.y) + (oa1.x + oa1.y);
    if (NP == 2) o += dpp_f<0xB1>(o);
    if (kp == 0) obuf[(size_t)t * 2048] = o;
  }
#pragma unroll
  for (int e = 0; e < E2; ++e) { st_out[(size_t)(2 * e) * 128] = s[e].x; st_out[(size_t)(2 * e + 1) * 128] = s[e].y; }
  __syncthreads();
}

__device__ __forceinline__ void scan_lru_prompt(CP& p, int l, int b, int cgp, int wv) {
  extern __shared__ __attribute__((aligned(16))) unsigned char smem_raw[];
  float* sA = (float*)smem_raw; float* sB = sA + 512;
  const int tid = opaque_tid(wv);
  const int ch = tid & 31, seg = tid >> 5, c = cgp * 32 + ch;
  const float* prep = (const float*)(p.ws + WS_PREP) + (size_t)(b * LP + seg * 129) * PREP_LD + c;
  float* obuf = (float*)(p.ws + WS_OBUF) + (size_t)(b * LP + seg * 129) * 2048 + 512 + c;
  float A = 1.f, B = 0.f;
#pragma unroll 1
  for (int t0 = 0; t0 < 129; t0 += 43) {
    float av[43], bv[43];
#pragma unroll
    for (int i = 0; i < 43; ++i) { av[i] = prep[(size_t)(t0 + i) * PREP_LD + P_LA]; bv[i] = prep[(size_t)(t0 + i) * PREP_LD + P_LB]; }
#pragma unroll
    for (int i = 0; i < 43; ++i) { B = av[i] * B + bv[i]; A *= av[i]; }
  }
  sA[seg * 32 + ch] = A; sB[seg * 32 + ch] = B;
  __syncthreads();
  float h = 0.f;
  for (int s2 = 0; s2 < seg; ++s2) h = sA[s2 * 32 + ch] * h + sB[s2 * 32 + ch];
#pragma unroll 1
  for (int t0 = 0; t0 < 129; t0 += 43) {
    float av[43], bv[43];
#pragma unroll
    for (int i = 0; i < 43; ++i) { av[i] = prep[(size_t)(t0 + i) * PREP_LD + P_LA]; bv[i] = prep[(size_t)(t0 + i) * PREP_LD + P_LB]; }
#pragma unroll
    for (int i = 0; i < 43; ++i) { h = av[i] * h + bv[i]; obuf[(size_t)(t0 + i) * 2048] = h; }
  }
  if (seg == 15) p.out[O_PL + (size_t)(l * 4 + b) * 512 + c] = h;
  __syncthreads();
}

__device__ __forceinline__ void scan_lru_sample(CP& p, int l, int b, int wv) {
  const int c = opaque_tid(wv);
  const float* prep = (const float*)(p.ws + WS_PREP) + (size_t)(NPR + b * 4) * PREP_LD;
  float* obuf = (float*)(p.ws + WS_OBUF) + (size_t)(NPR + b * 4) * 2048 + 512 + c;
  float h = p.in[4][(size_t)(l * 128 + b) * 512 + c];
#pragma unroll
  for (int t = 0; t < 4; ++t) { h = prep[(size_t)t * PREP_LD + P_LA + c] * h + prep[(size_t)t * PREP_LD + P_LB + c]; obuf[(size_t)t * 2048] = h; }
  p.out[O_SL + (size_t)(l * 128 + b) * 512 + c] = h;
}

__device__ __forceinline__ void scan_item2(CP& p, int l, int k, int wv) {
  if (k < 64) scan_lru_prompt(p, l, k >> 4, k & 15, wv);
  else if (k < 320) scan_sample<0>(p, l, k - 64, wv);
  else if (k < 448) scan_sample<1>(p, l, k - 320, wv);
  else if (k < 576) scan_sample<2>(p, l, k - 448, wv);
  else scan_lru_sample(p, l, k - 576, wv);
}

__device__ __forceinline__ void phase_scan(CP& p, int l, int wv) {
  extern __shared__ __attribute__((aligned(16))) unsigned char smem_raw[];
  float* sm = (float*)smem_raw;
  const int G = gridDim.x;
  const int tid = opaque_tid(wv);
  const int role = tid >> 8, rt = tid & 255;
#pragma unroll 1
  for (int it = blockIdx.x; it < 32; it += G) {
    if (role == 0) scan_prompt_delta_mfma(p, l, it >> 1, it & 1, sm, rt);
    else { for (int i = 0; i < NST + 1; ++i) __syncthreads(); }
    __syncthreads();
  }
#pragma unroll 1
  for (int it = blockIdx.x < 32 ? blockIdx.x + ((32 + G - 1 - blockIdx.x) / G) * G : blockIdx.x; it < 64; it += G) {
    const int i2 = it - 32;
    if (role == 0) scan_prompt_mfma<1>(p, l, i2 >> 1, i2 & 1, sm, rt);
    else scan_prompt_mfma<2>(p, l, i2 >> 1, i2 & 1, sm + 10240, rt);
    __syncthreads();
  }
  if (G >= 128) {
#pragma unroll 1
    for (int k = (int)blockIdx.x - 64; k >= 0 && k < 704; k += G - 64) scan_item2(p, l, k, wv);
    __syncthreads();
  } else {
#pragma unroll 1
    for (int k = blockIdx.x; k < 704; k += G) scan_item2(p, l, k, wv);
    __syncthreads();
  }
  __syncthreads();
}

__device__ __forceinline__ void phase_post(CP& p, int l, int wv) {
  const int tid = opaque_tid(wv), lane = tid & 63, w = tid >> 6;
  const float* obuf = (const float*)(p.ws + WS_OBUF);
  const float* proj = (const float*)(p.ws + WS_PROJ);
  unsigned* mix = (unsigned*)(p.ws + WS_MIX);
  const unsigned short* gb16 = (const unsigned short*)(p.ws + WS_GB16);
  const float2 na = *(const float2*)(p.in[14] + l * 128 + lane * 2);
  const float2 nc = *(const float2*)(p.in[24] + l * 128 + lane * 2);
  for (int r = blockIdx.x * 8 + w; r < MROWS; r += gridDim.x * 8) {
#pragma unroll 4
    for (int seg = 0; seg < 16; ++seg) {
      float2 x = *(const float2*)(obuf + (size_t)r * 2048 + seg * 128 + lane * 2);
      const int ca = C_GATE + seg * 128 + lane * 2;
      float sgx, sgy;
      if (ca >= GCOL0) { const unsigned u = *(const unsigned*)(gb16 + (size_t)r * 2048 + (ca - GCOL0)); sgx = siluf_(__uint_as_float(u << 16)); sgy = siluf_(__uint_as_float(u & 0xffff0000u)); }
      else { const float2 g = *(const float2*)(proj + (size_t)r * LDP + ca); sgx = siluf_(g.x); sgy = siluf_(g.y); }
      const int ty = seg >> 2;
      if (ty != 1) {
        const float ss = wave_allsum(x.x * x.x + x.y * x.y);
        const float sc = rsqrtf(ss * (1.f / 128.f) + 1e-6f);
        x.x *= sc; x.y *= sc;
        if (ty == 0) { x.x *= na.x; x.y *= na.y; }
        else if (ty == 2) { x.x *= nc.x; x.y *= nc.y; }
      }
      mix[(size_t)r * 1024 + seg * 64 + lane] = pack2(x.x * sgx, x.y * sgy);
    }
  }
}

__device__ __forceinline__ void phase_final(CP& p, int wv) {
  const int tid = opaque_tid(wv), lane = tid & 63, w = tid >> 6;
  const float* H = (const float*)(p.ws + WS_H);
  const float4* fw = (const float4*)p.in[26];
  for (int r = blockIdx.x * 8 + w; r < MROWS; r += gridDim.x * 8) {
    float* dst;
    if (r < NPR) { const int b = r / LP, t = r % LP; if (t < 16) continue; dst = p.out + O_YP + ((size_t)b * 2048 + (t - 16)) * D; }
    else dst = p.out + O_YS + (size_t)(r - NPR) * D;
    const float4* src = (const float4*)(H + (size_t)r * D);
    float4 v[8]; float ss = 0.f;
#pragma unroll
    for (int i = 0; i < 8; ++i) v[i] = src[lane + 64 * i];
    if (r >= 8192) {
      const float* pb = (const float*)(p.ws + WS_PB) + ((size_t)(((r >> 8) - 32) * 8) * 8) * 65536 + (size_t)(r & 255) * 256 + lane * 4;
#pragma unroll
      for (int i = 0; i < 8; ++i)
#pragma unroll
        for (int ch = 0; ch < 8; ++ch) { const float4 a = *(const float4*)(pb + (size_t)(i * 8 + ch) * 65536); v[i].x += a.x; v[i].y += a.y; v[i].z += a.z; v[i].w += a.w; }
    }
#pragma unroll
    for (int i = 0; i < 8; ++i) ss += v[i].x * v[i].x + v[i].y * v[i].y + v[i].z * v[i].z + v[i].w * v[i].w;
    ss = wave_allsum(ss);
    const float sc = rsqrtf(ss * (1.f / 2048.f) + 1e-6f);
#pragma unroll
    for (int i = 0; i < 8; ++i) {
      const float4 wv = fw[lane + 64 * i];
      ((float4*)dst)[lane + 64 * i] = make_float4(v[i].x * sc * wv.x, v[i].y * sc * wv.y, v[i].z * sc * wv.z, v[i].w * sc * wv.w);
    }
  }
}

#define XB_TMO      128
#define XB_XCNT(j)  (256  + 64 * (j))
#define XB_XSUB(j)  (1280 + 64 * (j))
#define XB_XGEN(j)  (2304 + 64 * (j))
#define XB_TOP      3328
#define XB_TOPGEN   3392
#define XCD_BAR_WORDS 3456
#define XB_SPIN_CAP (1u << 22)
#define LAS __attribute__((address_space(3)))
__device__ __forceinline__ unsigned xb_ld(unsigned* p)              { return __hip_atomic_load(p, __ATOMIC_RELAXED, __HIP_MEMORY_SCOPE_AGENT); }
__device__ __forceinline__ unsigned xb_add(unsigned* p, unsigned v) { return __hip_atomic_fetch_add(p, v, __ATOMIC_RELAXED, __HIP_MEMORY_SCOPE_AGENT); }
__device__ __forceinline__ unsigned xb_xcc_id() { return (unsigned)__builtin_amdgcn_s_getreg((3 << 11) | 20) & 0xFu; }
#define XB_SPIN(cond, bar) do { unsigned _sp = 0; while (cond) { __builtin_amdgcn_s_sleep(1); \
    if ((++_sp & 255u) == 0u) { if (xb_ld(&(bar)[XB_TMO])) break; if (_sp > XB_SPIN_CAP) { atomicAdd(&(bar)[XB_TMO], 1u); break; } } } } while (0)
__device__ __forceinline__ void xcd_barrier_complete(unsigned* bar, unsigned x, unsigned& nloc, unsigned& nx) {
  const unsigned G = gridDim.x;
  unsigned sum, cnt, mine, sp = 0u;
  for (;;) {
    sum = 0u; cnt = 0u; mine = 0u;
#pragma unroll
    for (unsigned j = 0; j < 16; ++j) { const unsigned c = xb_ld(&bar[XB_XCNT(j)]); sum += c; cnt += (c > 0u) ? 1u : 0u; mine = (j == x) ? c : mine; }
    if (sum == G) break;
    __builtin_amdgcn_s_sleep(1);
    if ((++sp & 255u) == 0u) { if (xb_ld(&bar[XB_TMO])) break; if (sp > XB_SPIN_CAP) { atomicAdd(&bar[XB_TMO], 1u); break; } }
  }
  nloc = mine > 0u ? mine : 1u; nx = cnt > 0u ? cnt : 1u;
}
__device__ __forceinline__ void fast_grid_sync(unsigned* bar, int wv) {
  extern __shared__ __attribute__((aligned(16))) unsigned char smem_raw[];
  asm volatile("s_waitcnt vmcnt(0)" ::: "memory");
  __syncthreads();
  if (wv == 0) {
    if (opaque_tid(wv) == 0) {
      volatile LAS unsigned* st = (volatile LAS unsigned*)(smem_raw + 131072);
      __builtin_amdgcn_s_waitcnt(0);
      const unsigned x = xb_xcc_id();
      unsigned nloc = st[0], nx = st[1];
      if (nloc == 0u) { xcd_barrier_complete(bar, x, nloc, nx); st[0] = nloc; st[1] = nx; }
      const unsigned old = xb_add(&bar[XB_XSUB(x)], 1u);
      const unsigned gen = old / nloc;
      if (old + 1u == (gen + 1u) * nloc) {
        __builtin_amdgcn_fence(__ATOMIC_RELEASE, "agent");
        asm volatile("s_waitcnt vmcnt(0)" ::: "memory");
        const unsigned og = xb_add(&bar[XB_TOP], 1u);
        const unsigned tg = og / nx;
        if (og + 1u == (tg + 1u) * nx) xb_add(&bar[XB_TOPGEN], 1u);
        else XB_SPIN(xb_ld(&bar[XB_TOPGEN]) == tg, bar);
        __builtin_amdgcn_fence(__ATOMIC_ACQUIRE, "agent");
        xb_add(&bar[XB_XGEN(x)], 1u);
        asm volatile("s_waitcnt vmcnt(0)" ::: "memory");
      } else {
        XB_SPIN(xb_ld(&bar[XB_XGEN(x)]) == gen, bar);
        __builtin_amdgcn_fence(__ATOMIC_ACQUIRE, "agent");
        asm volatile("s_waitcnt vmcnt(0)" ::: "memory");
      }
    }
  }
  __syncthreads();
}

__global__ void __launch_bounds__(NTHR) mega(P p_) {
  cg::grid_group grid = cg::this_grid();
  const int wv = __builtin_amdgcn_readfirstlane((int)(threadIdx.x >> 6));
#define GSYNC(j_) fast_grid_sync((unsigned*)((*getp()).ws + WS_BAR), wv)
  { extern __shared__ __attribute__((aligned(16))) unsigned char smem_raw[];
    if (wv == 0 && opaque_tid(wv) == 0) { volatile LAS unsigned* st = (volatile LAS unsigned*)(smem_raw + 131072); st[0] = 0u; st[1] = 0u;
      (void)xb_add(&((unsigned*)((*getp()).ws + WS_BAR))[XB_XCNT(xb_xcc_id())], 1u); }
    __syncthreads(); }
  phase_convert(*getp(), wv);
  if ((*getp()).pad != 0) grid.sync();
  GSYNC(0);
#pragma unroll 1
  for (int l = 0; l < 4; ++l) {
    phase_norm(*getp(), wv, l > 0);
    GSYNC(1);
    { CP& p = *getp();
      phase_gemm<0>((const bf16*)(p.ws + WS_XN), (const bf16*)(p.ws + WS_WTIN) + (size_t)l * LDW * 2048, (float*)(p.ws + WS_PROJ), p.mpad, p.ldp, wv, p.ldq, (unsigned short*)(p.ws + WS_GB16)); }
    {
      const int G_ = gridDim.x, nt4 = 875 - 3 * G_;
      if (l < 3 && G_ == 256 && (int)blockIdx.x >= nt4) convert_weights(*getp(), wv, (l + 1) * CV_TL, (l + 2) * CV_TL, (int)blockIdx.x - nt4, G_ - nt4);
      else if (l < 3 && G_ != 256) convert_weights(*getp(), wv, (l + 1) * CV_TL, (l + 2) * CV_TL, blockIdx.x, G_); }
    GSYNC(2);
    phase_prep(*getp(), l, wv);
    GSYNC(3);
    phase_prep2(*getp(), wv);
    GSYNC(4);
    phase_scan(*getp(), l, wv);
    GSYNC(5);
    phase_post(*getp(), l, wv);
    GSYNC(6);
    { CP& p = *getp();
      phase_gemm_out((const bf16*)(p.ws + WS_MIX), (const bf16*)(p.ws + WS_WTOUT) + (size_t)l * 2048 * 2048, (float*)(p.ws + WS_H), (float*)(p.ws + WS_PB), p.mpad, p.dm, wv); }
    GSYNC(7);
  }
  phase_final(*getp(), wv);
}

#undef GSYNC
extern "C" void kernel_launch(void* const* d_in, const int* in_sizes, int n_in, void* d_out, int out_size, void* d_ws, size_t ws_size,
                              hipStream_t stream) {
  static int grid = 0;
  if (grid == 0) {
    int dev = 0, cus = 0, per_cu = 0;
    hipGetDevice(&dev);
    hipDeviceGetAttribute(&cus, hipDeviceAttributeMultiprocessorCount, dev);
    hipFuncSetAttribute((const void*)mega, hipFuncAttributeMaxDynamicSharedMemorySize, LDS_BYTES);
    hipOccupancyMaxActiveBlocksPerMultiprocessor(&per_cu, (const void*)mega, NTHR, LDS_BYTES);
    if (per_cu < 1) per_cu = 1;
    if (per_cu > 1) per_cu = 1;
    grid = cus * per_cu;
    if (ws_size < WS_END) { fprintf(stderr, "workspace too small: %zu < %zu\n", ws_size, (size_t)WS_END); }
  }
  P p{};
  for (int i = 0; i < 27; ++i) p.in[i] = (const float*)d_in[i];
  p.out = (float*)d_out;
  p.ws = (unsigned char*)d_ws;
  p.mpad = MPAD; p.ldp = LDW; p.dm = D; p.pad = 0; p.ldq = LDP; p.pad2 = 0;
  (void)hipMemsetAsync((unsigned char*)d_ws + WS_BAR, 0, 16384, stream);
  void* args[] = {&p};
  hipError_t e = hipLaunchCooperativeKernel((const void*)mega, dim3(grid), dim3(NTHR), args, LDS_BYTES, stream);
  if (e != hipSuccess) fprintf(stderr, "cooperative launch failed: %s (grid %d)\n", hipGetErrorString(e), grid);
}
```

```cpp
#include <hip/hip_runtime.h>
#include <hip/hip_bf16.h>
#include <hip/hip_cooperative_groups.h>
#include <cstdio>
namespace cg = cooperative_groups;

using bf16 = __hip_bfloat16;
using bf16x8 = __attribute__((ext_vector_type(8))) short;
using f32x4 = __attribute__((ext_vector_type(4))) float;

constexpr int D = 2048;
constexpr int LP = 2064;
constexpr int NPR = 4 * LP;
constexpr int NSR = 512;
constexpr int MROWS = NPR + NSR;
constexpr int MPAD = 8960;
constexpr int INW = 6168;
constexpr int LDW = 6400;
constexpr int LDP = 4352;
constexpr int GCOL0 = 4352;
constexpr int NTHR = 512;
constexpr int LDS_BYTES = 131072 + 64;

constexpr int C_ALPHA = 1536, C_BETA = 1540, C_XB = 1544, C_QC = 2056, C_KC = 2312, C_VC = 2568, C_RC = 3080,
              C_QD = 3096, C_KD = 3352, C_VD = 3608, C_GATE = 4120;
constexpr int P_QA = 0, P_KA = 512, P_VA = 1024, P_AB = 1536, P_LA = 1544, P_LB = 2056, P_QC = 2568, P_KC = 2824,
              P_AC = 3080, P_QD = 3336, P_KD = 3592, P_WA = 3848, P_KH = 4360, P_GC = 4872, P_DM = 4880, PREP_LD = 4944;

constexpr size_t O_YP = 0;
constexpr size_t O_YS = O_YP + (size_t)4 * 2048 * 2048;
constexpr size_t O_PD = O_YS + (size_t)128 * 4 * 2048;
constexpr size_t O_PDC = O_PD + (size_t)4 * 4 * 4 * 128 * 128;
constexpr size_t O_PL = O_PDC + (size_t)4 * 4 * 3 * 1536;
constexpr size_t O_PLC = O_PL + (size_t)4 * 4 * 512;
constexpr size_t O_PG = O_PLC + (size_t)4 * 4 * 3 * 512;
constexpr size_t O_PR = O_PG + (size_t)4 * 4 * 4 * 64 * 128;
constexpr size_t O_SD = O_PR + (size_t)4 * 4 * 4 * 64 * 128;
constexpr size_t O_SDC = O_SD + (size_t)4 * 128 * 4 * 128 * 128;
constexpr size_t O_SL = O_SDC + (size_t)4 * 128 * 3 * 1536;
constexpr size_t O_SLC = O_SL + (size_t)4 * 128 * 512;
constexpr size_t O_SG = O_SLC + (size_t)4 * 128 * 3 * 512;
constexpr size_t O_SR = O_SG + (size_t)4 * 128 * 4 * 64 * 128;

constexpr size_t WS_WTIN = 0;
constexpr size_t WS_WTOUT = WS_WTIN + (size_t)4 * LDW * 2048 * 2;
constexpr size_t WS_H = WS_WTOUT + (size_t)4 * 2048 * 2048 * 2;
constexpr size_t WS_XN = WS_H + (size_t)MPAD * 2048 * 4;
constexpr size_t WS_PROJ = WS_XN + (size_t)MPAD * 2048 * 2;
constexpr size_t WS_PREP = WS_PROJ + (size_t)MPAD * LDP * 4;
constexpr size_t WS_OBUF = WS_PREP + (size_t)MROWS * PREP_LD * 4;
constexpr size_t WS_MIX = WS_XN;
constexpr size_t WS_WTG = WS_OBUF + (size_t)MROWS * 2048 * 4;
constexpr size_t WS_GDEC = WS_WTG + (size_t)4 * 4 * 2 * 128 * 128 * 2;
constexpr size_t WS_BAR = WS_GDEC + (size_t)(MROWS / 16) * 256 * 4;
constexpr size_t WS_PB = WS_BAR + 16384;
constexpr size_t WS_GB16 = WS_PB + (size_t)24 * 8 * 65536 * 4;
constexpr size_t WS_END = WS_GB16 + (size_t)MPAD * 2048 * 2;

struct P { const float* in[27]; float* out; unsigned char* ws; int mpad, ldp, dm, pad, ldq, pad2; };
typedef const __attribute__((address_space(4))) P CP;
__device__ __forceinline__ CP* getp() { CP* pp = (CP*)__builtin_amdgcn_kernarg_segment_ptr(); asm volatile("" : "+s"(pp)); return pp; }

__device__ __forceinline__ unsigned short f2bf(float f) {
  unsigned u = __float_as_uint(f);
  u += 0x7fffu + ((u >> 16) & 1u);
  return (unsigned short)(u >> 16);
}
typedef float cvf2_t __attribute__((ext_vector_type(2)));
typedef __bf16 cvb2_t __attribute__((ext_vector_type(2)));
__device__ __forceinline__ unsigned cvtpk(float lo, float hi) { cvf2_t v = {lo, hi}; return __builtin_bit_cast(unsigned, __builtin_convertvector(v, cvb2_t)); }
__device__ __forceinline__ unsigned pack2(float a, float b) { return (unsigned)f2bf(a) | ((unsigned)f2bf(b) << 16); }
__device__ __forceinline__ float sigmoidf_(float x) { return __builtin_amdgcn_rcpf(1.f + __expf(-x)); }
__device__ __forceinline__ float siluf_(float x) { return x * __builtin_amdgcn_rcpf(1.f + __expf(-x)); }
__device__ __forceinline__ float softplusf_(float x) {
  const float e = __expf(fminf(x, 15.f));
  const float mid = __logf(1.f + e);
  return x > 15.f ? x : (x < -6.f ? e * (1.f - 0.5f * e) : mid);
}
template <int CTRL> __device__ __forceinline__ float dpp_f(float x) {
  return __builtin_bit_cast(float, __builtin_amdgcn_update_dpp(0, __builtin_bit_cast(int, x), CTRL, 0xf, 0xf, true));
}

typedef __attribute__((ext_vector_type(4))) unsigned u32x4;
__device__ __forceinline__ bf16x8 mkfrag(unsigned a, unsigned b, unsigned c, unsigned d) { u32x4 t = {a, b, c, d}; return __builtin_bit_cast(bf16x8, t); }
__device__ __forceinline__ float row16_allsum(float x) {
  x += dpp_f<0x128>(x);
  x += dpp_f<0x124>(x);
  x += dpp_f<0x122>(x);
  x += dpp_f<0x121>(x);
  return x;
}
__device__ __forceinline__ float wave_allsum(float x) {
  x = row16_allsum(x);
  const int xi = __builtin_bit_cast(int, x);
  const float r0 = __builtin_bit_cast(float, __builtin_amdgcn_readlane(xi, 0));
  const float r1 = __builtin_bit_cast(float, __builtin_amdgcn_readlane(xi, 16));
  const float r2 = __builtin_bit_cast(float, __builtin_amdgcn_readlane(xi, 32));
  const float r3 = __builtin_bit_cast(float, __builtin_amdgcn_readlane(xi, 48));
  return (r0 + r1) + (r2 + r3);
}

__device__ __forceinline__ int opaque_tid(int wv) { unsigned m = ~0u; asm volatile("" : "+s"(m)); int t = wv * 64 + (int)__builtin_amdgcn_mbcnt_hi(m, __builtin_amdgcn_mbcnt_lo(m, 0u)); asm volatile("" : "+v"(t)); return t; }

constexpr int CV_TIN = 32 * 100, CV_TOUT = 32 * 32, CV_TL = CV_TIN + CV_TOUT;
__device__ __forceinline__ void convert_weights(CP& p, int wv, int t_lo, int t_hi, int bidx, int nb) {
  extern __shared__ __attribute__((aligned(16))) unsigned char smem_raw[];
  float* sm = (float*)smem_raw;
  const int tid = opaque_tid(wv);
  bf16* wtin = (bf16*)(p.ws + WS_WTIN);
  bf16* wtout = (bf16*)(p.ws + WS_WTOUT);
  constexpr int TIN = CV_TIN, TL = CV_TL;
  {
    const int kk0 = tid >> 4, n4 = (tid & 15) * 4;
    const int nn = tid >> 3, k8 = (tid & 7) * 8;
    float4 va = make_float4(0.f, 0.f, 0.f, 0.f), vb = va; float sa = 1.f, sb = 1.f;
#define CV_DECODE(t_) \
    const int l_ = (t_) / TL; int r_ = (t_) % TL; const float* src_; int nsrc_, kt_, nt_; const float* nw_; unsigned short* dst_; \
    if (r_ < TIN) { kt_ = r_ / 100; nt_ = r_ % 100; src_ = p.in[10] + (size_t)l_ * 2048 * INW; nsrc_ = INW; \
                    dst_ = (unsigned short*)(wtin + (size_t)l_ * LDW * 2048); nw_ = p.in[9] + l_ * 2048; } \
    else { r_ -= TIN; kt_ = r_ / 32; nt_ = r_ % 32; src_ = p.in[25] + (size_t)l_ * 2048 * 2048; nsrc_ = 2048; \
           dst_ = (unsigned short*)(wtout + (size_t)l_ * 2048 * 2048); nw_ = nullptr; }
#define CV_LOAD(t_) do { CV_DECODE(t_) (void)dst_; \
      const int n_ = nt_ * 64 + n4, ka_ = kt_ * 64 + kk0, kb_ = ka_ + 32; \
      va = make_float4(0.f, 0.f, 0.f, 0.f); vb = va; \
      if (n_ < nsrc_) { va = *(const float4*)(src_ + (size_t)ka_ * nsrc_ + n_); vb = *(const float4*)(src_ + (size_t)kb_ * nsrc_ + n_); } \
      sa = nw_ ? nw_[ka_] : 1.f; sb = nw_ ? nw_[kb_] : 1.f; } while (0)
    int t = t_lo + bidx;
    if (t < t_hi) CV_LOAD(t);
    int cur = 0;
    for (; t < t_hi; t += nb) {
      float* sb_ = sm + cur * (64 * 65);
      sb_[kk0 * 65 + n4 + 0] = va.x * sa; sb_[kk0 * 65 + n4 + 1] = va.y * sa; sb_[kk0 * 65 + n4 + 2] = va.z * sa; sb_[kk0 * 65 + n4 + 3] = va.w * sa;
      sb_[(kk0 + 32) * 65 + n4 + 0] = vb.x * sb; sb_[(kk0 + 32) * 65 + n4 + 1] = vb.y * sb; sb_[(kk0 + 32) * 65 + n4 + 2] = vb.z * sb; sb_[(kk0 + 32) * 65 + n4 + 3] = vb.w * sb;
      if (t + nb < t_hi) CV_LOAD(t + nb);
      __syncthreads();
      {
        CV_DECODE(t) (void)src_; (void)nsrc_; (void)nw_;
        uint4 o;
        o.x = pack2(sb_[(k8 + 0) * 65 + nn], sb_[(k8 + 1) * 65 + nn]);
        o.y = pack2(sb_[(k8 + 2) * 65 + nn], sb_[(k8 + 3) * 65 + nn]);
        o.z = pack2(sb_[(k8 + 4) * 65 + nn], sb_[(k8 + 5) * 65 + nn]);
        o.w = pack2(sb_[(k8 + 6) * 65 + nn], sb_[(k8 + 7) * 65 + nn]);
        *(uint4*)(dst_ + (size_t)(nt_ * 64 + nn) * 2048 + kt_ * 64 + k8) = o;
      }
      cur ^= 1;
    }
#undef CV_LOAD
#undef CV_DECODE
    __syncthreads();
  }
}

__device__ __forceinline__ void phase_convert(CP& p, int wv) {
  const int tid = opaque_tid(wv);
  convert_weights(p, wv, 0, CV_TL, blockIdx.x, gridDim.x);
  float* H = (float*)(p.ws + WS_H);
  const size_t gtid = (size_t)blockIdx.x * NTHR + tid, gsz = (size_t)gridDim.x * NTHR;
  for (size_t idx = gtid; idx < (size_t)MPAD * 512; idx += gsz) {
    const int r = (int)(idx >> 9), c4 = (int)(idx & 511) * 4;
    float4 v = make_float4(0.f, 0.f, 0.f, 0.f);
    if (r < NPR) { const int b = r / LP, t = r % LP;
      v = t < 16 ? *(const float4*)(p.in[8] + (size_t)t * D + c4) : *(const float4*)(p.in[0] + ((size_t)b * 2048 + (t - 16)) * D + c4); }
    else if (r < MROWS) v = *(const float4*)(p.in[1] + (size_t)(r - NPR) * D + c4);
    *(float4*)(H + (size_t)r * D + c4) = v;
  }
  {
    unsigned short* wtg = (unsigned short*)(p.ws + WS_WTG);
    for (size_t idx = gtid; idx < (size_t)4 * 4 * 2 * 128 * 128; idx += gsz) {
      const int c = (int)(idx & 127), d = (int)((idx >> 7) & 127), g = (int)((idx >> 14) & 1), blk = (int)((idx >> 15) & 3), l = (int)(idx >> 17);
      const float* srcg = (g == 0 ? p.in[17] : p.in[19]) + ((size_t)((l * 4 + blk) * 128 + c)) * 128 + d;
      wtg[idx] = f2bf(*srcg);
    }
  }
  unsigned* mixz = (unsigned*)(p.ws + WS_MIX + (size_t)MROWS * 2048 * 2);
  for (size_t idx = gtid; idx < (size_t)(MPAD - MROWS) * 1024; idx += gsz) mixz[idx] = 0u;
}

__device__ __forceinline__ void phase_norm(CP& p, int wv, int fix) {
  const int tid = opaque_tid(wv), lane = tid & 63, w = tid >> 6;
  float* H = (float*)(p.ws + WS_H);
  const float* PB = (const float*)(p.ws + WS_PB);
  unsigned short* XN = (unsigned short*)(p.ws + WS_XN);
  for (int r = blockIdx.x * 8 + w; r < MPAD; r += gridDim.x * 8) {
    uint2* dst = (uint2*)(XN + (size_t)r * D);
    if (r >= MROWS) {
#pragma unroll
      for (int i = 0; i < 8; ++i) dst[lane + 64 * i] = make_uint2(0u, 0u);
      continue;
    }
    float4* src = (float4*)(H + (size_t)r * D);
    float4 v[8]; float ss = 0.f;
#pragma unroll
    for (int i = 0; i < 8; ++i) v[i] = src[lane + 64 * i];
    if (fix && r >= 8192) {
      const float* pb = PB + ((size_t)(((r >> 8) - 32) * 8) * 8) * 65536 + (size_t)(r & 255) * 256 + lane * 4;
#pragma unroll
      for (int i = 0; i < 8; ++i) {
#pragma unroll
        for (int ch = 0; ch < 8; ++ch) { const float4 a = *(const float4*)(pb + (size_t)(i * 8 + ch) * 65536); v[i].x += a.x; v[i].y += a.y; v[i].z += a.z; v[i].w += a.w; }
        src[lane + 64 * i] = v[i];
      }
    }
#pragma unroll
    for (int i = 0; i < 8; ++i) ss += v[i].x * v[i].x + v[i].y * v[i].y + v[i].z * v[i].z + v[i].w * v[i].w;
    ss = wave_allsum(ss);
    const float sc = __builtin_amdgcn_rsqf(ss * (1.f / 2048.f) + 1e-6f);
#pragma unroll
    for (int i = 0; i < 8; ++i) dst[lane + 64 * i] = make_uint2(pack2(v[i].x * sc, v[i].y * sc), pack2(v[i].z * sc, v[i].w * sc));
  }
}

constexpr int BM = 256, BK = 64, HALF = 128, NXCD = 8, WGM = 8, HT = HALF * BK;
__device__ __forceinline__ int lds_byte(int r, int c) {
  int st = (r >> 4) * 2 + (c >> 5), rr = r & 15, cc = c & 31, ob = rr * 64 + cc * 2;
  return st * 1024 + (ob ^ (((ob >> 9) & 1) << 5));
}
__device__ __forceinline__ void stage_rc(int b, int& R, int& C) {
  int st = b / 1024, sb = b % 1024, swz = sb ^ (((sb >> 9) & 1) << 5);
  R = (st >> 1) * 16 + swz / 64; C = (st & 1) * 32 + (swz % 64) / 2;
}

template <int MODE> __device__ __forceinline__ void gemm_tile(const bf16*A,const bf16*Bt,float*C,int M,int N,int tile,int wv,int pmo,int pno,int kt0,int ntk,int ldc,int cpart,unsigned short*C16=nullptr){ constexpr int K=2048;
  extern __shared__ __attribute__((aligned(16))) bf16 shm[];
  const int tix = opaque_tid(wv);
  #define SA(b,h) (shm+((b)*2+(h))*HT)
  #define SB(b,h) (shm+(4+(b)*2+(h))*HT)
  unsigned soff0,soff1; {int _r,_c; stage_rc(tix*16,_r,_c); soff0=_r*K+_c; stage_rc(tix*16+8192,_r,_c); soff1=_r*K+_c;}
  #define STAGE(P,BASE,br,kt) do{const bf16* _gb=BASE+(long)(br)*K+(long)((kt)+kt0)*BK; \
      __builtin_amdgcn_global_load_lds((const unsigned*)(_gb+soff0),(unsigned*)((char*)(P)+tix*16),16,0,0); \
      __builtin_amdgcn_global_load_lds((const unsigned*)(_gb+soff1),(unsigned*)((char*)(P)+tix*16+8192),16,0,0);}while(0)
  #define LDA(dst,b,h) for(int m=0;m<4;++m)for(int k=0;k<2;++k) \
    dst[m][k]=*reinterpret_cast<const bf16x8*>((char*)SA(b,h)+lds_byte(wr*64+m*16+fr,k*32+fq*8))
  #define LDB(dst,b,h) for(int n=0;n<2;++n)for(int k=0;k<2;++k) \
    dst[n][k]=*reinterpret_cast<const bf16x8*>((char*)SB(b,h)+lds_byte(wc*32+n*16+fr,k*32+fq*8))
  #define MMA(ai,bj,At,Bt) do{__builtin_amdgcn_s_setprio(1); \
    for(int m=0;m<4;++m)for(int n=0;n<2;++n)for(int k=0;k<2;++k) \
      acc[ai][bj][m][n]=__builtin_amdgcn_mfma_f32_16x16x32_bf16(At[m][k],Bt[n][k],acc[ai][bj][m][n],0,0,0); \
    __builtin_amdgcn_s_setprio(0);}while(0)
  #define WAIT_V(n) asm volatile("s_waitcnt vmcnt(" #n ")":::"memory")
  #define WAIT_L(n) asm volatile("s_waitcnt lgkmcnt(" #n ")":::"memory")
  #define BAR __builtin_amdgcn_s_barrier()
  #define SCHED __builtin_amdgcn_sched_barrier(0)

  int nM=M/BM,nN=N/BM,nwg=nM*nN,wgid=tile;
  {int q=nwg/NXCD,r=nwg%NXCD,xcd=wgid%NXCD,off=wgid/NXCD;
   wgid=(xcd<r?xcd*(q+1):r*(q+1)+(xcd-r)*q)+off;}
  int nig=WGM*nN,gid=wgid/nig,fm=gid*WGM,gsz=min(nM-fm,WGM);
  int pm=fm+((wgid%nig)%gsz),pn=(wgid%nig)/gsz; if(pmo>=0){pm=pmo;pn=pno;} int brow=pm*BM,bcol=pn*BM;
  int wid=tix>>6,lane=tix&63,wr=wid>>2,wc=wid&3,fr=lane&15,fq=lane>>4;
  f32x4 acc[2][2][4][2]={};
  bf16x8 At[4][2],B0[2][2],B1[2][2];
  int nt=ntk;
  STAGE(SB(0,0),Bt,bcol,0); STAGE(SA(0,0),A,brow,0);
  STAGE(SB(0,1),Bt,bcol+HALF,0); STAGE(SA(0,1),A,brow+HALF,0);
  if(wr==1)BAR;
  WAIT_V(4); BAR;
  STAGE(SB(1,0),Bt,bcol,1); STAGE(SA(1,0),A,brow,1); STAGE(SB(1,1),Bt,bcol+HALF,1);
  WAIT_V(6); BAR;
  for(int t=0;t<nt-2;t+=2){
    LDB(B0,0,0); SCHED; LDA(At,0,0); STAGE(SA(1,1),A,brow+HALF,t+1);
    WAIT_L(8); BAR; WAIT_L(0); MMA(0,0,At,B0); BAR; SCHED;
    LDB(B1,0,1); STAGE(SB(0,0),Bt,bcol,t+2);
    BAR; WAIT_L(0); MMA(0,1,At,B1); BAR;
    LDA(At,0,1); STAGE(SA(0,0),A,brow,t+2);
    BAR; WAIT_L(0); MMA(1,0,At,B0); BAR; SCHED;
    STAGE(SB(0,1),Bt,bcol+HALF,t+2);
    WAIT_V(6); BAR; MMA(1,1,At,B1); BAR;
    LDB(B0,1,0); SCHED; LDA(At,1,0); STAGE(SA(0,1),A,brow+HALF,t+2);
    WAIT_L(8); BAR; WAIT_L(0); MMA(0,0,At,B0); BAR; SCHED;
    LDB(B1,1,1); STAGE(SB(1,0),Bt,bcol,t+3);
    BAR; WAIT_L(0); MMA(0,1,At,B1); BAR;
    LDA(At,1,1); STAGE(SA(1,0),A,brow,t+3);
    BAR; WAIT_L(0); MMA(1,0,At,B0); BAR; SCHED;
    STAGE(SB(1,1),Bt,bcol+HALF,t+3);
    WAIT_V(6); BAR; MMA(1,1,At,B1); BAR;
  }
  { LDB(B0,0,0); LDA(At,0,0); STAGE(SA(1,1),A,brow+HALF,nt-1);
    BAR; WAIT_L(0); MMA(0,0,At,B0); BAR;
    LDB(B1,0,1); BAR; WAIT_L(0); MMA(0,1,At,B1); BAR;
    LDA(At,0,1); WAIT_V(4); BAR; WAIT_L(0); MMA(1,0,At,B0); MMA(1,1,At,B1); BAR; }
  { LDB(B0,1,0); LDA(At,1,0); WAIT_V(2); BAR; WAIT_L(0); MMA(0,0,At,B0); BAR;
    LDB(B1,1,1); WAIT_V(0); BAR; WAIT_L(0); MMA(0,1,At,B1); BAR;
    LDA(At,1,1); BAR; WAIT_L(0); MMA(1,0,At,B0); MMA(1,1,At,B1); BAR; }
  if(wr==0)BAR;
  {
    float* eps = (float*)shm;
    const int er = tix >> 5, ec = (tix & 31) * 4;
    float* cbase = C + (long)((cpart ? 0 : brow) + er) * ldc + ((cpart ? 0 : bcol) + ec);
#pragma unroll
    for (int ai = 0; ai < 2; ++ai)
#pragma unroll
      for (int bj = 0; bj < 2; ++bj) {
        __syncthreads();
#pragma unroll
        for (int m = 0; m < 4; ++m)
#pragma unroll
          for (int n = 0; n < 2; ++n)
#pragma unroll
            for (int j = 0; j < 4; ++j) eps[(wr * 64 + m * 16 + fq * 4 + j) * 132 + wc * 32 + n * 16 + fr] = acc[ai][bj][m][n][j];
        __syncthreads();
        if (MODE == 0 && C16 != nullptr && pn >= 17) {
#pragma unroll
          for (int i = 0; i < 8; ++i) {
            const float4 v = *(const float4*)(eps + (er + 16 * i) * 132 + ec);
            uint2 o; o.x = cvtpk(v.x, v.y); o.y = cvtpk(v.z, v.w);
            *(uint2*)(C16 + (long)(brow + er + ai * HALF + 16 * i) * 2048 + ((pn - 17) * 256 + bj * HALF + ec)) = o;
          }
        } else {
#pragma unroll
          for (int i = 0; i < 8; ++i) {
            float4 v = *(const float4*)(eps + (er + 16 * i) * 132 + ec);
            float4* gp = (float4*)(cbase + (long)(ai * HALF + 16 * i) * ldc + bj * HALF);
            if (MODE == 1) { const float4 o = *gp; v.x += o.x; v.y += o.y; v.z += o.z; v.w += o.w; }
            *gp = v;
          }
        }
      }
    __syncthreads();
  }
}
#undef SA
#undef SB
#undef STAGE
#undef LDA
#undef LDB
#undef MMA
template <int MODE> __device__ __forceinline__ void phase_gemm(const bf16* A, const bf16* Bt, float* C, int M, int N, int wv, int ldc, unsigned short* C16) {
  const int nwg = (M / 256) * (N / 256);
  for (int t = blockIdx.x; t < nwg; t += gridDim.x) gemm_tile<MODE>(A, Bt, C, M, N, t, wv, -1, 0, 0, 32, ldc, 0, C16);
  __syncthreads();
}

__device__ __forceinline__ void phase_gemm_out(const bf16* A, const bf16* Bt, float* H, float* PB, int M, int N, int wv) {
#pragma unroll 1
  for (int t = blockIdx.x; t < 256; t += gridDim.x) gemm_tile<1>(A, Bt, H, M, N, t, wv, t >> 3, t & 7, 0, 32, N, 0);
#pragma unroll 1
  for (int i = blockIdx.x; i < 192; i += gridDim.x) {
    const int lt = i >> 3, ch = i & 7;
    gemm_tile<0>(A, Bt, PB + (size_t)i * 65536, M, N, 0, wv, 32 + (lt >> 3), lt & 7, ch * 4, 4, 256, 1);
  }
  __syncthreads();
}

__device__ __forceinline__ void phase_prep(CP& p, int l, int wv) {
  extern __shared__ __attribute__((aligned(16))) unsigned char smem_raw[];
  float* xs_t = (float*)smem_raw;
  unsigned short* xs16 = (unsigned short*)(smem_raw + 40960);
  float* gl = (float*)(smem_raw + 57600);
  const unsigned short* wtg = (const unsigned short*)(p.ws + WS_WTG);
  const int tid = opaque_tid(wv), lane = tid & 63, w = tid >> 6;
  const float* proj = (const float*)(p.ws + WS_PROJ);
  float* prep = (float*)(p.ws + WS_PREP);
  const float* conv_a = p.in[11] + (size_t)l * 4 * 1536;
  const float* cst_a = p.in[3] + (size_t)l * 128 * 3 * 1536;
  const float* conv_b = p.in[15] + (size_t)l * 4 * 512;
  const float* cbb = p.in[16] + (size_t)l * 512;
  const float* cst_b = p.in[5] + (size_t)l * 128 * 3 * 512;
  const float* wa = p.in[17] + (size_t)l * 4 * 128 * 128;
  const float* ba = p.in[18] + (size_t)l * 512;
  const float* wx = p.in[19] + (size_t)l * 4 * 128 * 128;
  const float* bx = p.in[20] + (size_t)l * 512;
  const float* lam = p.in[21] + (size_t)l * 512;
  const float* w2 = p.in[22] + (size_t)l * 16 * 256;
  const float* b2 = p.in[23] + (size_t)l * 256;
  const float* a_log = p.in[12] + l * 4;
  const float* dt_bias = p.in[13] + l * 4;

  for (int tt = blockIdx.x; tt < MROWS / 16; tt += gridDim.x) {
    const int r0 = tt * 16;
    const bool pr = r0 < NPR;
    const int t0 = pr ? (r0 % LP) : 0;
    const int s0 = r0 - NPR;
    if (tid < 64) {
      const int i = tid >> 2, hh = tid & 3;
      const float* pr_ = proj + (size_t)(r0 + i) * LDP;
      const float g = -expf(a_log[hh]) * softplusf_(pr_[C_ALPHA + hh] + dt_bias[hh]);
      prep[(size_t)(r0 + i) * PREP_LD + P_AB + hh] = expf(g);
      prep[(size_t)(r0 + i) * PREP_LD + P_AB + 4 + hh] = sigmoidf_(pr_[C_BETA + hh]);
    }
    {
      const int c = tid;
      const float w0 = conv_b[0 * 512 + c], w1 = conv_b[1 * 512 + c], w2_ = conv_b[2 * 512 + c], w3 = conv_b[3 * 512 + c];
      const float bias = cbb[c];
      if (pr) {
        float xw[19];
#pragma unroll
        for (int q = 0; q < 19; ++q) {
          const int t = t0 - 3 + q;
          xw[q] = 0.f;
          if (t >= 0) xw[q] = proj[(size_t)(r0 - 3 + q) * LDP + C_XB + c];
        }
#pragma unroll
        for (int i = 0; i < 16; ++i) { const float xv_ = bias + w3 * xw[i + 3] + w2_ * xw[i + 2] + w1 * xw[i + 1] + w0 * xw[i]; xs_t[c * 20 + i] = xv_; xs16[i * 520 + c] = f2bf(xv_); }
      } else {
#pragma unroll
        for (int bq = 0; bq < 4; ++bq) {
          const int bb = (s0 >> 2) + bq;
          float xw[7];
#pragma unroll
          for (int q = 0; q < 3; ++q) xw[q] = cst_b[((size_t)bb * 3 + q) * 512 + c];
#pragma unroll
          for (int q = 0; q < 4; ++q) xw[3 + q] = proj[(size_t)(r0 + bq * 4 + q) * LDP + C_XB + c];
#pragma unroll
          for (int q = 0; q < 4; ++q) { const float xv_ = bias + w3 * xw[q + 3] + w2_ * xw[q + 2] + w1 * xw[q + 1] + w0 * xw[q]; xs_t[c * 20 + bq * 4 + q] = xv_; xs16[(bq * 4 + q) * 520 + c] = f2bf(xv_); }
        }
      }
    }
    __syncthreads();
    {
      const int blk = w >> 1, g = w & 1;
      const unsigned short* wg = wtg + ((size_t)((l * 4 + blk) * 2 + g) * 128) * 128;
      const int mrow = lane & 15, q = lane >> 4;
      bf16x8 afr[4];
#pragma unroll
      for (int ks = 0; ks < 4; ++ks) afr[ks] = *(const bf16x8*)(xs16 + mrow * 520 + blk * 128 + ks * 32 + q * 8);
      f32x4 acc[8];
#pragma unroll
      for (int nt = 0; nt < 8; ++nt) {
        acc[nt] = (f32x4){0.f, 0.f, 0.f, 0.f};
#pragma unroll
        for (int ks = 0; ks < 4; ++ks) {
          const bf16x8 bfr = *(const bf16x8*)(wg + (size_t)(nt * 16 + mrow) * 128 + ks * 32 + q * 8);
          acc[nt] = __builtin_amdgcn_mfma_f32_16x16x32_bf16(afr[ks], bfr, acc[nt], 0, 0, 0);
        }
      }
#pragma unroll
      for (int nt = 0; nt < 8; ++nt)
#pragma unroll
        for (int jj = 0; jj < 4; ++jj) gl[(g * 16 + q * 4 + jj) * 512 + blk * 128 + nt * 16 + mrow] = acc[nt][jj];
    }
    __syncthreads();
    {
      const int ch = tid;
      const float bav = ba[ch], bxv = bx[ch];
      const float sp = softplusf_(-lam[ch]);
#pragma unroll
      for (int i = 0; i < 16; ++i) {
        const float xb = xs_t[ch * 20 + i];
        const float rg = sigmoidf_(gl[i * 512 + ch] + bav), ig = sigmoidf_(gl[(16 + i) * 512 + ch] + bxv);
        const float log_a = -8.f * rg * sp;
        const float a = __expf(log_a);
        const float x2 = 2.f * log_a;
        const float om = x2 > -0.02f ? -x2 * (1.f + x2 * (0.5f + x2 * (1.f / 6.f))) : 1.f - a * a;
        const float bc = __builtin_amdgcn_sqrtf(om) * (ig * xb);
        prep[(size_t)(r0 + i) * PREP_LD + P_LA + ch] = a;
        prep[(size_t)(r0 + i) * PREP_LD + P_LB + ch] = bc;
      }
    }
    __syncthreads();
  }
  {
    const int gw = blockIdx.x * 8 + wv, GW = gridDim.x * 8;
#pragma unroll 1
    for (int it = gw; it < (MROWS / 16) * 44; it += GW) {
      const int tt = it / 44, sub = it % 44;
      const int r0 = tt * 16;
      const bool pr = r0 < NPR;
      const int t0 = pr ? (r0 % LP) : 0;
      const int s0 = r0 - NPR;
    if (sub < 24) {
      const int vec = sub % 12, hf = sub / 12, ib = hf * 8;
      const int cc = vec * 128 + lane * 2;
      const float2 wv0 = *(const float2*)(conv_a + 0 * 1536 + cc), wv1 = *(const float2*)(conv_a + 1 * 1536 + cc);
      const float2 wv2 = *(const float2*)(conv_a + 2 * 1536 + cc), wv3 = *(const float2*)(conv_a + 3 * 1536 + cc);
#define CONV_OUT(i_, x0, x1, x2, x3) do { \
        float y0 = wv3.x * (x0).x + wv2.x * (x1).x + wv1.x * (x2).x + wv0.x * (x3).x; \
        float y1 = wv3.y * (x0).y + wv2.y * (x1).y + wv1.y * (x2).y + wv0.y * (x3).y; \
        y0 = siluf_(y0); y1 = siluf_(y1); \
        if (vec < 8) { const float ss = wave_allsum(y0 * y0 + y1 * y1); float sc = __builtin_amdgcn_rsqf(ss + 1e-6f); \
          if (vec < 4) sc *= 0.08838834764831845f; y0 *= sc; y1 *= sc; } \
        *(float2*)(prep + (size_t)(r0 + (i_)) * PREP_LD + cc) = make_float2(y0, y1); } while (0)
      if (pr) {
        float2 xw[11];
#pragma unroll
        for (int q = 0; q < 11; ++q) {
          const int t = t0 + ib - 3 + q;
          const float* ptr = proj + (size_t)(r0 + ib - 3 + q) * LDP + cc;
          xw[q] = (t >= 0) ? *(const float2*)ptr : make_float2(0.f, 0.f);
        }
#pragma unroll
        for (int ii = 0; ii < 8; ++ii) CONV_OUT(ib + ii, xw[ii + 3], xw[ii + 2], xw[ii + 1], xw[ii]);
      } else {
#pragma unroll 2
        for (int ii = 0; ii < 8; ++ii) {
          const int i = ib + ii;
          const int tl = (s0 + i) & 3, bb = (s0 + i) >> 2;
          const float* cs = cst_a + (size_t)bb * 3 * 1536 + cc;
          const float* pj = proj + (size_t)(r0 + i) * LDP + cc;
          const float2 x0 = *(const float2*)pj;
          const float2 x1 = tl >= 1 ? *(const float2*)(pj - LDP) : *(const float2*)(cs + (2 + tl) * 1536);
          const float2 x2 = tl >= 2 ? *(const float2*)(pj - 2 * LDP) : *(const float2*)(cs + (1 + tl) * 1536);
          const float2 x3 = tl >= 3 ? *(const float2*)(pj - 3 * LDP) : *(const float2*)(cs + (0 + tl) * 1536);
          CONV_OUT(i, x0, x1, x2, x3);
        }
      }
#undef CONV_OUT
    }
    else if (sub < 28) {
      const int cq = sub - 24, ch = cq * 64 + lane;
      float rcv[4];
#pragma unroll
      for (int m = 0; m < 4; ++m) rcv[m] = proj[(size_t)(r0 + (lane >> 4) + 4 * m) * LDP + C_RC + (lane & 15)];
      float w2v[16];
#pragma unroll
      for (int jj = 0; jj < 16; ++jj) w2v[jj] = w2[jj * 256 + ch];
      const float b2v = b2[ch];
      float qv[16], kv[16];
#pragma unroll
      for (int i = 0; i < 16; ++i) { qv[i] = proj[(size_t)(r0 + i) * LDP + C_QC + ch]; kv[i] = proj[(size_t)(r0 + i) * LDP + C_KC + ch]; }
      float P = 1.f;
#pragma unroll
      for (int i = 0; i < 16; ++i) {
        float z = b2v;
#pragma unroll
        for (int jj = 0; jj < 16; ++jj)
          z += __builtin_bit_cast(float, __builtin_amdgcn_readlane(__builtin_bit_cast(int, rcv[i >> 2]), (i & 3) * 16 + jj)) * w2v[jj];
        const float al = __expf(-softplusf_(-z) * (1.f / 16.f));
        float* pp = prep + (size_t)(r0 + i) * PREP_LD;
        if (pr) { P *= al; pp[P_QC + ch] = qv[i] * 0.125f * P; pp[P_KC + ch] = kv[i] * __builtin_amdgcn_rcpf(P); }
        else { pp[P_QC + ch] = qv[i] * 0.125f; pp[P_KC + ch] = kv[i]; pp[P_AC + ch] = al; }
      }
      if (pr) ((float*)(p.ws + WS_GDEC))[(size_t)tt * 256 + ch] = P;
    } else {
      const int i = sub - 28;
      const int pos = pr ? (t0 + i) : (16384 + ((s0 + i) & 3));
      const float* pr_ = proj + (size_t)(r0 + i) * LDP;
      float* pp = prep + (size_t)(r0 + i) * PREP_LD;
      const int f = lane & 31, hb = lane >> 5;
      const float freq = __builtin_amdgcn_exp2f(-(float)f * (13.287712379549449f / 32.f));
      const float ang = (float)pos * freq;
      double rev = (double)ang * 0.15915494309189535;
      rev -= floor(rev);
      const float fr_ = (float)rev;
      const float cs = __builtin_amdgcn_cosf(fr_), sn = __builtin_amdgcn_sinf(fr_);
#pragma unroll
      for (int m = 0; m < 2; ++m) {
        const int hh = hb + 2 * m;
        float gq = 1.f, gk = 0.125f;
        if (pr) { const float lgam = __builtin_amdgcn_logf(1.f - __builtin_amdgcn_exp2f(-5.f - (float)hh)); gq = __builtin_amdgcn_exp2f((float)(i + 1) * lgam); gk = 0.125f * __builtin_amdgcn_exp2f(-(float)(i + 1) * lgam); }
        const float q1 = pr_[C_QD + hh * 64 + f] * gq, q2 = pr_[C_QD + hh * 64 + 32 + f] * gq;
        const float k1 = pr_[C_KD + hh * 64 + f] * gk, k2 = pr_[C_KD + hh * 64 + 32 + f] * gk;
        pp[P_QD + hh * 64 + f] = q1 * cs - q2 * sn;
        pp[P_QD + hh * 64 + 32 + f] = q2 * cs + q1 * sn;
        pp[P_KD + hh * 64 + f] = k1 * cs - k2 * sn;
        pp[P_KD + hh * 64 + 32 + f] = k2 * cs + k1 * sn;
      }
    }
    }
  }
  const size_t gtid = (size_t)blockIdx.x * NTHR + tid, gsz = (size_t)gridDim.x * NTHR;
  for (size_t idx = gtid; idx < (size_t)132 * 3 * 2048; idx += gsz) {
    const int c = (int)(idx & 2047), jj = (int)((idx >> 11) % 3), bb = (int)(idx / (2048 * 3));
    const size_t row = bb < 4 ? (size_t)(bb * LP + LP - 3 + jj) : (size_t)(NPR + (bb - 4) * 4 + 1 + jj);
    if (c < 1536) {
      const float v = proj[row * LDP + c];
      if (bb < 4) p.out[O_PDC + ((size_t)(l * 4 + bb) * 3 + jj) * 1536 + c] = v;
      else p.out[O_SDC + ((size_t)(l * 128 + bb - 4) * 3 + jj) * 1536 + c] = v;
    } else {
      const int c2 = c - 1536;
      const float v = proj[row * LDP + C_XB + c2];
      if (bb < 4) p.out[O_PLC + ((size_t)(l * 4 + bb) * 3 + jj) * 512 + c2] = v;
      else p.out[O_SLC + ((size_t)(l * 128 + bb - 4) * 3 + jj) * 512 + c2] = v;
    }
  }
}

using f2 = __attribute__((ext_vector_type(2))) float;
constexpr int NST = LP / 16;

template <int MODE>
__device__ __forceinline__ void scan_prompt_half(CP& p, int l, int bh, int cg, float* sm, int rt) {
  constexpr int DK = MODE == 0 ? 128 : 64;
  constexpr int EPL = DK / 16, E2 = EPL / 2;
  constexpr int QOFF = MODE == 0 ? P_QA : (MODE == 1 ? P_QC : P_QD);
  constexpr int KOFF = MODE == 0 ? P_KA : (MODE == 1 ? P_KC : P_KD);
  constexpr int OB = MODE == 0 ? 0 : (MODE == 1 ? 1024 : 1536);
  constexpr int BUFSZ = 48 * DK + 256 + 32;
  const int lane = rt & 63, wl = rt >> 6;
  const int b = bh >> 2, h = bh & 3;
  const int j = lane & 15, cl = wl * 4 + (lane >> 4);
  const float* prep = (const float*)(p.ws + WS_PREP) + (size_t)(b * LP) * PREP_LD;
  const float* proj = (const float*)(p.ws + WS_PROJ) + (size_t)(b * LP) * LDP;
  float* obuf = (float*)(p.ws + WS_OBUF) + (size_t)(b * LP) * 2048;
  f2 s[E2];
#pragma unroll
  for (int e = 0; e < E2; ++e) s[e] = (f2){0.f, 0.f};
  const float gamma = 1.f - exp2f(-5.f - (float)h);
  const int lt0 = rt / (DK / 4), lc0 = (rt % (DK / 4)) * 4;
  const int lt1 = (rt + 256) / (DK / 4);
  const bool ld_v = rt < 64;
  const int vt = rt >> 2, vc = (rt & 3) * 4;
  float4 rq0_0 = make_float4(0, 0, 0, 0), rq1_0 = rq0_0, rk0_0 = rq0_0, rk1_0 = rq0_0, ral_0 = rq0_0, rv_0 = rq0_0; float rsc_0 = 0.f;
  float4 rq0_1 = rq0_0, rq1_1 = rq0_0, rk0_1 = rq0_0, rk1_1 = rq0_0, ral_1 = rq0_0, rv_1 = rq0_0; float rsc_1 = 0.f;
#define GLOAD(st_, S) do { const int t0_ = (st_) * 16; \
    { const float* rp_ = prep + (size_t)(t0_ + lt0) * PREP_LD; rq0_##S = *(const float4*)(rp_ + QOFF + h * DK + lc0); \
      rk0_##S = *(const float4*)(rp_ + KOFF + h * DK + lc0); if (MODE == 1) ral_##S = *(const float4*)(rp_ + P_AC + h * 64 + lc0); } \
    if (MODE == 0) { const float* rp_ = prep + (size_t)(t0_ + lt1) * PREP_LD; rq1_##S = *(const float4*)(rp_ + QOFF + h * DK + lc0); \
      rk1_##S = *(const float4*)(rp_ + KOFF + h * DK + lc0); } \
    if (ld_v) { if (MODE == 0) rv_##S = *(const float4*)(prep + (size_t)(t0_ + vt) * PREP_LD + P_VA + h * 128 + cg * 16 + vc); \
      else rv_##S = *(const float4*)(proj + (size_t)(t0_ + vt) * LDP + (MODE == 1 ? C_VC : C_VD) + h * 128 + cg * 16 + vc); } \
    if (MODE == 0 && rt < 32) rsc_##S = prep[(size_t)(t0_ + (rt & 15)) * PREP_LD + (rt < 16 ? P_AB : P_AB + 4) + h]; } while (0)
#define LSTORE(bf_, S) do { *(float4*)((bf_) + lt0 * DK + lc0) = rq0_##S; *(float4*)((bf_) + 16 * DK + lt0 * DK + lc0) = rk0_##S; \
    if (MODE == 1) *(float4*)((bf_) + 32 * DK + lt0 * DK + lc0) = ral_##S; \
    if (MODE == 0) { *(float4*)((bf_) + lt1 * DK + lc0) = rq1_##S; *(float4*)((bf_) + 16 * DK + lt1 * DK + lc0) = rk1_##S; } \
    if (ld_v) *(float4*)((bf_) + 48 * DK + vt * 16 + vc) = rv_##S; \
    if (MODE == 0 && rt < 32) (bf_)[48 * DK + 256 + rt] = rsc_##S; } while (0)
  GLOAD(0, 0);
  LSTORE(sm, 0);
  GLOAD(1, 1);
  __syncthreads();
  auto stage = [&](const int st, const int SL) __attribute__((always_inline)) {
    const float* bf = sm + (st & 1) * BUFSZ;
    float* bn = sm + ((st + 1) & 1) * BUFSZ;
    if (st + 2 < NST) { if (SL == 0) GLOAD(st + 2, 0); else GLOAD(st + 2, 1); }
    float okeep = 0.f;
    f2 kkb[3][E2], qqb[3][E2]; float vvb[3], aab[3], beb[3]; float4 alb[3];
#define LOADTOK(ti_, S_) do { \
      _Pragma("unroll") for (int e4 = 0; e4 < EPL / 4; ++e4) { \
        const float4 k4 = *(const float4*)(bf + 16 * DK + (ti_) * DK + j * EPL + e4 * 4); \
        const float4 q4 = *(const float4*)(bf + (ti_) * DK + j * EPL + e4 * 4); \
        kkb[S_][e4 * 2 + 0] = (f2){k4.x, k4.y}; kkb[S_][e4 * 2 + 1] = (f2){k4.z, k4.w}; \
        qqb[S_][e4 * 2 + 0] = (f2){q4.x, q4.y}; qqb[S_][e4 * 2 + 1] = (f2){q4.z, q4.w}; } \
      vvb[S_] = bf[48 * DK + (ti_) * 16 + cl]; \
      if (MODE == 0) { aab[S_] = bf[48 * DK + 256 + (ti_)]; beb[S_] = bf[48 * DK + 256 + 16 + (ti_)]; } \
      if (MODE == 1) alb[S_] = *(const float4*)(bf + 32 * DK + (ti_) * DK + j * EPL); } while (0)
    LOADTOK(0, 0);
    LOADTOK(1, 1);
#pragma unroll
    for (int ti = 0; ti < 16; ++ti) {
      constexpr int dummy_ = 0; (void)dummy_;
      const int cs = ti % 3;
      if (ti + 2 < 16) { LOADTOK(ti + 2, (ti + 2) % 3); }
      __builtin_amdgcn_sched_barrier(0);
      f2 kk[E2], qq[E2];
#pragma unroll
      for (int e = 0; e < E2; ++e) { kk[e] = kkb[cs][e]; qq[e] = qqb[cs][e]; }
      const float vv = vvb[cs];
      if (MODE == 0) {
        f2 ra = kk[0] * s[0];
#pragma unroll
        for (int e = 1; e < E2; ++e) ra = kk[e] * s[e] + ra;
        const float r = row16_allsum(ra.x + ra.y);
        const float a = aab[cs], be = beb[cs];
        const float dd = be * (vv - a * r);
        const f2 a2 = (f2){a, a}, d2 = (f2){dd, dd};
#pragma unroll
        for (int e = 0; e < E2; ++e) s[e] = kk[e] * d2 + a2 * s[e];
      } else if (MODE == 1) {
        const float4 a4 = alb[cs];
        const f2 v2 = (f2){vv, vv};
        s[0] = kk[0] * v2 + ((f2){a4.x, a4.y}) * s[0];
        s[1] = kk[1] * v2 + ((f2){a4.z, a4.w}) * s[1];
      } else {
        const f2 v2 = (f2){vv, vv}, g2 = (f2){gamma, gamma};
#pragma unroll
        for (int e = 0; e < E2; ++e) s[e] = kk[e] * v2 + g2 * s[e];
      }
      f2 oa = qq[0] * s[0];
#pragma unroll
      for (int e = 1; e < E2; ++e) oa = qq[e] * s[e] + oa;
      const float o = row16_allsum(oa.x + oa.y);
      if (j == ti) okeep = o;
    }
#undef LOADTOK
    if (st + 1 < NST) { if (SL == 0) LSTORE(bn, 1); else LSTORE(bn, 0); }
    obuf[(size_t)(st * 16 + j) * 2048 + OB + h * 128 + cg * 16 + cl] = okeep;
    __syncthreads();
    };
#pragma unroll 1
  for (int st = 0; st + 1 < NST; st += 2) { stage(st, 0); stage(st + 1, 1); }
  stage(NST - 1, 0);
#undef GLOAD
#undef LSTORE
  float* so = p.out + (MODE == 0 ? O_PD : (MODE == 1 ? O_PG : O_PR)) + ((size_t)(l * 4 + b) * 4 + h) * DK * 128;
#pragma unroll
  for (int e = 0; e < E2; ++e) {
    so[(size_t)(j * EPL + 2 * e) * 128 + cg * 16 + cl] = s[e].x;
    so[(size_t)(j * EPL + 2 * e + 1) * 128 + cg * 16 + cl] = s[e].y;
  }
}

__device__ __forceinline__ void phase_prep2(CP& p, int wv) {
  extern __shared__ __attribute__((aligned(16))) unsigned char smem_raw[];
  const int tid = opaque_tid(wv), hd = tid >> 7, d = tid & 127;
  float* hs = (float*)smem_raw + hd * 4864;
  float* kS = hs; float* vS = hs + 2112; float* AS = hs + 4224; float* TS = hs + 4496; float* lgS = hs + 4768; float* gcS = hs + 4784; float* beS = hs + 4800;
  float* prep = (float*)(p.ws + WS_PREP);
#pragma unroll 1
  for (int tile = blockIdx.x; tile < 4 * NST; tile += gridDim.x) {
    const int r0 = tile * 16;
#pragma unroll
    for (int i = 0; i < 16; ++i) {
      kS[i * 132 + d] = prep[(size_t)(r0 + i) * PREP_LD + P_KA + hd * 128 + d];
      vS[i * 132 + d] = prep[(size_t)(r0 + i) * PREP_LD + P_VA + hd * 128 + d];
    }
    if (d < 16) { lgS[d] = logf(prep[(size_t)(r0 + d) * PREP_LD + P_AB + hd]); beS[d] = prep[(size_t)(r0 + d) * PREP_LD + P_AB + 4 + hd]; }
    __syncthreads();
    if (d < 16) { float g = 0.f; for (int m = 0; m <= d; ++m) g += lgS[m]; gcS[d] = g; }
    float dots[2];
#pragma unroll
    for (int e2 = 0; e2 < 2; ++e2) {
      const int e = d + 128 * e2, i = e >> 4, m = e & 15;
      float acc = 0.f;
      if (m < i) {
        const float4* ki = (const float4*)(kS + i * 132); const float4* km = (const float4*)(kS + m * 132);
#pragma unroll 8
        for (int c = 0; c < 32; ++c) { const float4 x = ki[c], y = km[c]; acc += x.x * y.x + x.y * y.y + x.z * y.z + x.w * y.w; }
      }
      dots[e2] = acc;
    }
    __syncthreads();
#pragma unroll
    for (int e2 = 0; e2 < 2; ++e2) {
      const int e = d + 128 * e2, i = e >> 4, m = e & 15;
      AS[i * 17 + m] = (m < i) ? beS[i] * dots[e2] * __expf(gcS[i] - gcS[m]) : 0.f;
    }
    __syncthreads();
    if (d < 16) {
      float tcol[16];
#pragma unroll
      for (int i = 0; i < 16; ++i) {
        float t = (i == d) ? 1.f : 0.f;
#pragma unroll
        for (int m = 0; m < i; ++m) t -= AS[i * 17 + m] * tcol[m];
        tcol[i] = t;
      }
#pragma unroll
      for (int i = 0; i < 16; ++i) TS[i * 17 + d] = tcol[i];
    }
    __syncthreads();
    {
      float xk[16], xv[16];
#pragma unroll
      for (int m = 0; m < 16; ++m) { const float bm = beS[m]; xk[m] = bm * __expf(gcS[m]) * kS[m * 132 + d]; xv[m] = bm * vS[m * 132 + d]; }
      const float g15 = gcS[15];
#pragma unroll
      for (int i = 0; i < 16; ++i) {
        float W = 0.f, U = 0.f;
#pragma unroll
        for (int m = 0; m <= i; ++m) { const float t = TS[i * 17 + m]; W += t * xk[m]; U += t * xv[m]; }
        float* pp = prep + (size_t)(r0 + i) * PREP_LD;
        pp[P_WA + hd * 128 + d] = W;
        pp[P_VA + hd * 128 + d] = U;
        pp[P_KH + hd * 128 + d] = kS[i * 132 + d] * __expf(g15 - gcS[i]);
      }
      if (d < 16) prep[(size_t)(r0 + d) * PREP_LD + P_GC + hd] = __expf(gcS[d]);
#pragma unroll
      for (int e2 = 0; e2 < 2; ++e2) {
        const int e = d + 128 * e2, i = e >> 4, m = e & 15;
        prep[(size_t)(r0 + i) * PREP_LD + P_DM + hd * 16 + m] = (m <= i) ? __expf(gcS[i] - gcS[m]) : 0.f;
      }
    }
    __syncthreads();
  }
}

__device__ __forceinline__ void scan_prompt_delta_mfma(CP& p, int l, int bh, int half, float* sm, int rt) {
  constexpr int BUFSZ = 10464;
  const int lane = rt & 63, wl = rt >> 6, n = lane & 15, q = lane >> 4;
  const int b = bh >> 2, h = bh & 3;
  const int col0 = half * 64 + wl * 16;
  const float* prep = (const float*)(p.ws + WS_PREP) + (size_t)(b * LP) * PREP_LD;
  float* obuf = (float*)(p.ws + WS_OBUF) + (size_t)(b * LP) * 2048 + h * 128 + col0 + n;
  f32x4 St[8];
#pragma unroll
  for (int kt = 0; kt < 8; ++kt) St[kt] = (f32x4){0.f, 0.f, 0.f, 0.f};
  const int lt0 = rt >> 5, lt1 = lt0 + 8, lc = (rt & 31) * 4;
  const int tt_ = rt & 15, tc = (rt >> 4) * 4;
  float4 rq0_0, rq1_0, rk0_0, rk1_0, rw0_0, rw1_0, rh0_0, rh1_0, ru_0, rd_0 = make_float4(0, 0, 0, 0); float rg_0 = 0.f;
  float4 rq0_1, rq1_1, rk0_1, rk1_1, rw0_1, rw1_1, rh0_1, rh1_1, ru_1, rd_1 = make_float4(0, 0, 0, 0); float rg_1 = 0.f;
  rq0_0 = rq1_0 = rk0_0 = rk1_0 = rw0_0 = rw1_0 = rh0_0 = rh1_0 = ru_0 = make_float4(0, 0, 0, 0);
  rq0_1 = rq1_1 = rk0_1 = rk1_1 = rw0_1 = rw1_1 = rh0_1 = rh1_1 = ru_1 = make_float4(0, 0, 0, 0);
#define GLOADD(st_, S) do { const float* ra_ = prep + (size_t)((st_) * 16 + lt0) * PREP_LD + h * 128 + lc; \
    const float* rb_ = prep + (size_t)((st_) * 16 + lt1) * PREP_LD + h * 128 + lc; \
    rq0_##S = *(const float4*)(ra_ + P_QA); rq1_##S = *(const float4*)(rb_ + P_QA); rk0_##S = *(const float4*)(ra_ + P_KA); rk1_##S = *(const float4*)(rb_ + P_KA); \
    rw0_##S = *(const float4*)(ra_ + P_WA); rw1_##S = *(const float4*)(rb_ + P_WA); \
    const float* rt__ = prep + (size_t)((st_) * 16 + tt_) * PREP_LD + h * 128; \
    rh0_##S = *(const float4*)(rt__ + P_KH + tc); rh1_##S = *(const float4*)(rt__ + P_KH + 64 + tc); \
    ru_##S = *(const float4*)(rt__ + P_VA + half * 64 + tc); \
    if (rt < 16) rg_##S = prep[(size_t)((st_) * 16 + rt) * PREP_LD + P_GC + h]; \
    if (rt < 64) rd_##S = *(const float4*)(prep + (size_t)((st_) * 16 + (rt >> 2)) * PREP_LD + P_DM + h * 16 + (rt & 3) * 4); } while (0)
#define LSTORED(bf_, S) do { *(float4*)((bf_) + lt0 * 132 + lc) = rq0_##S; *(float4*)((bf_) + lt1 * 132 + lc) = rq1_##S; \
    *(float4*)((bf_) + 2112 + lt0 * 132 + lc) = rk0_##S; *(float4*)((bf_) + 2112 + lt1 * 132 + lc) = rk1_##S; \
    *(float4*)((bf_) + 4224 + lt0 * 132 + lc) = rw0_##S; *(float4*)((bf_) + 4224 + lt1 * 132 + lc) = rw1_##S; \
    (bf_)[6336 + (tc + 0) * 20 + tt_] = rh0_##S.x; (bf_)[6336 + (tc + 1) * 20 + tt_] = rh0_##S.y; (bf_)[6336 + (tc + 2) * 20 + tt_] = rh0_##S.z; (bf_)[6336 + (tc + 3) * 20 + tt_] = rh0_##S.w; \
    (bf_)[6336 + (tc + 64) * 20 + tt_] = rh1_##S.x; (bf_)[6336 + (tc + 65) * 20 + tt_] = rh1_##S.y; (bf_)[6336 + (tc + 66) * 20 + tt_] = rh1_##S.z; (bf_)[6336 + (tc + 67) * 20 + tt_] = rh1_##S.w; \
    (bf_)[8896 + (tc + 0) * 20 + tt_] = ru_##S.x; (bf_)[8896 + (tc + 1) * 20 + tt_] = ru_##S.y; (bf_)[8896 + (tc + 2) * 20 + tt_] = ru_##S.z; (bf_)[8896 + (tc + 3) * 20 + tt_] = ru_##S.w; \
    if (rt < 16) (bf_)[10176 + rt] = rg_##S; \
    if (rt < 64) *(float4*)((bf_) + 10208 + rt * 4) = rd_##S; } while (0)
  GLOADD(0, 0);
  LSTORED(sm, 0);
  GLOADD(1, 1);
  __syncthreads();
  auto stage = [&](const int st, const int SL) __attribute__((always_inline)) {
    const float* bf = sm + (st & 1) * BUFSZ;
    float* bn = sm + ((st + 1) & 1) * BUFSZ;
    if (st + 2 < NST) { if (SL == 0) GLOADD(st + 2, 0); else GLOADD(st + 2, 1); }
    const float4 egm = *(const float4*)(bf + 10176 + 4 * q);
    const float4 dm4 = *(const float4*)(bf + 10208 + n * 16 + 4 * q);
    const float e15 = bf[10176 + 15];
    f32x4 ws = (f32x4){0.f, 0.f, 0.f, 0.f}, qs = ws, pt = ws;
#pragma unroll
    for (int ks = 0; ks < 4; ++ks) {
      const int o0 = n * 132 + 32 * ks + 4 * q;
      const float4 qa = *(const float4*)(bf + o0), qb = *(const float4*)(bf + o0 + 16);
      const float4 ka = *(const float4*)(bf + 2112 + o0), kb = *(const float4*)(bf + 2112 + o0 + 16);
      const float4 wa = *(const float4*)(bf + 4224 + o0), wb = *(const float4*)(bf + 4224 + o0 + 16);
      const bf16x8 QF = mkfrag(cvtpk(qa.x, qa.y), cvtpk(qa.z, qa.w), cvtpk(qb.x, qb.y), cvtpk(qb.z, qb.w));
      const bf16x8 KF = mkfrag(cvtpk(ka.x, ka.y), cvtpk(ka.z, ka.w), cvtpk(kb.x, kb.y), cvtpk(kb.z, kb.w));
      const bf16x8 WF = mkfrag(cvtpk(wa.x, wa.y), cvtpk(wa.z, wa.w), cvtpk(wb.x, wb.y), cvtpk(wb.z, wb.w));
      const bf16x8 SB = mkfrag(cvtpk(St[2 * ks][0], St[2 * ks][1]), cvtpk(St[2 * ks][2], St[2 * ks][3]),
                               cvtpk(St[2 * ks + 1][0], St[2 * ks + 1][1]), cvtpk(St[2 * ks + 1][2], St[2 * ks + 1][3]));
      ws = __builtin_amdgcn_mfma_f32_16x16x32_bf16(WF, SB, ws, 0, 0, 0);
      qs = __builtin_amdgcn_mfma_f32_16x16x32_bf16(QF, SB, qs, 0, 0, 0);
      pt = __builtin_amdgcn_mfma_f32_16x16x32_bf16(KF, QF, pt, 0, 0, 0);
    }
    const float4 u4 = *(const float4*)(bf + 8896 + (wl * 16 + n) * 20 + 4 * q);
    const float vn0 = u4.x - ws[0], vn1 = u4.y - ws[1], vn2 = u4.z - ws[2], vn3 = u4.w - ws[3];
    const bf16x8 VNF = mkfrag(cvtpk(vn0, vn1), cvtpk(vn2, vn3), 0u, 0u);
    const float p0 = pt[0] * dm4.x, p1 = pt[1] * dm4.y, p2 = pt[2] * dm4.z, p3 = pt[3] * dm4.w;
    const bf16x8 PF = mkfrag(cvtpk(p0, p1), cvtpk(p2, p3), 0u, 0u);
    f32x4 qsc;
    qsc[0] = qs[0] * egm.x; qsc[1] = qs[1] * egm.y; qsc[2] = qs[2] * egm.z; qsc[3] = qs[3] * egm.w;
    const f32x4 o = __builtin_amdgcn_mfma_f32_16x16x32_bf16(PF, VNF, qsc, 0, 0, 0);
#pragma unroll
    for (int r = 0; r < 4; ++r) obuf[(size_t)(st * 16 + 4 * q + r) * 2048] = o[r];
#pragma unroll
    for (int kt = 0; kt < 8; ++kt) {
      const float4 k4 = *(const float4*)(bf + 6336 + (16 * kt + n) * 20 + 4 * q);
      const bf16x8 KTF = mkfrag(cvtpk(k4.x, k4.y), cvtpk(k4.z, k4.w), 0u, 0u);
      f32x4 sc;
      sc[0] = St[kt][0] * e15; sc[1] = St[kt][1] * e15; sc[2] = St[kt][2] * e15; sc[3] = St[kt][3] * e15;
      St[kt] = __builtin_amdgcn_mfma_f32_16x16x32_bf16(KTF, VNF, sc, 0, 0, 0);
    }
    if (st + 1 < NST) { if (SL == 0) LSTORED(bn, 1); else LSTORED(bn, 0); }
    __syncthreads();
    };
#pragma unroll 1
  for (int st = 0; st + 1 < NST; st += 2) { stage(st, 0); stage(st + 1, 1); }
  stage(NST - 1, 0);
#undef GLOADD
#undef LSTORED
  float* so = p.out + O_PD + ((size_t)(l * 4 + b) * 4 + h) * 128 * 128 + col0 + n;
#pragma unroll
  for (int kt = 0; kt < 8; ++kt)
#pragma unroll
    for (int r = 0; r < 4; ++r) so[(size_t)(16 * kt + 4 * q + r) * 128] = St[kt][r];
}

template <int MODE>
__device__ __forceinline__ void scan_prompt_mfma(CP& p, int l, int bh, int half, float* sm, int rt) {
  constexpr int QOFF = MODE == 1 ? P_QC : P_QD, KOFF = MODE == 1 ? P_KC : P_KD, OB = MODE == 1 ? 1024 : 1536;
  constexpr int BUFSZ = 4800;
  const int lane = rt & 63, wl = rt >> 6, n = lane & 15, q = lane >> 4;
  const int b = bh >> 2, h = bh & 3;
  const int col0 = half * 64 + wl * 16;
  const float* prep = (const float*)(p.ws + WS_PREP) + (size_t)(b * LP) * PREP_LD + h * 64;
  const float* proj = (const float*)(p.ws + WS_PROJ) + (size_t)(b * LP) * LDP + (MODE == 1 ? C_VC : C_VD) + h * 128 + half * 64;
  float* obuf = (float*)(p.ws + WS_OBUF) + (size_t)(b * LP) * 2048 + OB + h * 128 + col0 + n;
  const float* gdec = (const float*)(p.ws + WS_GDEC) + (size_t)(b * NST) * 256 + h * 64;
  f32x4 St[4];
#pragma unroll
  for (int kt = 0; kt < 4; ++kt) St[kt] = (f32x4){0.f, 0.f, 0.f, 0.f};
  float g16 = 1.f - exp2f(-5.f - (float)h);
  g16 *= g16; g16 *= g16; g16 *= g16; g16 *= g16;
  const int lt = rt >> 4, lc = (rt & 15) * 4;
  const int tt_ = rt & 15, tc = (rt >> 4) * 4;
  float4 rq_0 = make_float4(0, 0, 0, 0), rk_0 = rq_0, rv_0 = rq_0, rp_0 = rq_0, rx_0 = rq_0, rq_1 = rq_0, rk_1 = rq_0, rv_1 = rq_0, rp_1 = rq_0, rx_1 = rq_0;
#define GLOADM(st_, S) do { const float* rp__ = prep + (size_t)((st_) * 16 + lt) * PREP_LD; \
    rq_##S = *(const float4*)(rp__ + QOFF + lc); rk_##S = *(const float4*)(rp__ + KOFF + lc); \
    rx_##S = *(const float4*)(prep + (size_t)((st_) * 16 + tt_) * PREP_LD + KOFF + tc); \
    rv_##S = *(const float4*)(proj + (size_t)((st_) * 16 + tt_) * LDP + tc); \
    if (MODE == 1 && rt < 16) rp_##S = *(const float4*)(gdec + (size_t)(st_) * 256 + rt * 4); } while (0)
#define LSTOREM(bf_, S) do { *(float4*)((bf_) + lt * 68 + lc) = rq_##S; *(float4*)((bf_) + 1088 + lt * 68 + lc) = rk_##S; \
    (bf_)[2176 + (tc + 0) * 20 + tt_] = rx_##S.x; (bf_)[2176 + (tc + 1) * 20 + tt_] = rx_##S.y; \
    (bf_)[2176 + (tc + 2) * 20 + tt_] = rx_##S.z; (bf_)[2176 + (tc + 3) * 20 + tt_] = rx_##S.w; \
    (bf_)[3456 + (tc + 0) * 20 + tt_] = rv_##S.x; (bf_)[3456 + (tc + 1) * 20 + tt_] = rv_##S.y; \
    (bf_)[3456 + (tc + 2) * 20 + tt_] = rv_##S.z; (bf_)[3456 + (tc + 3) * 20 + tt_] = rv_##S.w; \
    if (MODE == 1 && rt < 16) *(float4*)((bf_) + 4736 + rt * 4) = rp_##S; } while (0)
  GLOADM(0, 0);
  LSTOREM(sm, 0);
  GLOADM(1, 1);
  __syncthreads();
  auto stage = [&](const int st, const int SL) __attribute__((always_inline)) {
    const float* bf = sm + (st & 1) * BUFSZ;
    float* bn = sm + ((st + 1) & 1) * BUFSZ;
    if (st + 2 < NST) { if (SL == 0) GLOADM(st + 2, 0); else GLOADM(st + 2, 1); }
    bf16x8 QF[2], KF[2], SB[2];
#pragma unroll
    for (int ks = 0; ks < 2; ++ks) {
      const float4 qa = *(const float4*)(bf + n * 68 + 32 * ks + 4 * q), qb = *(const float4*)(bf + n * 68 + 32 * ks + 16 + 4 * q);
      const float4 ka = *(const float4*)(bf + 1088 + n * 68 + 32 * ks + 4 * q), kb = *(const float4*)(bf + 1088 + n * 68 + 32 * ks + 16 + 4 * q);
      QF[ks] = mkfrag(cvtpk(qa.x, qa.y), cvtpk(qa.z, qa.w), cvtpk(qb.x, qb.y), cvtpk(qb.z, qb.w));
      KF[ks] = mkfrag(cvtpk(ka.x, ka.y), cvtpk(ka.z, ka.w), cvtpk(kb.x, kb.y), cvtpk(kb.z, kb.w));
      SB[ks] = mkfrag(cvtpk(St[2 * ks][0], St[2 * ks][1]), cvtpk(St[2 * ks][2], St[2 * ks][3]),
                      cvtpk(St[2 * ks + 1][0], St[2 * ks + 1][1]), cvtpk(St[2 * ks + 1][2], St[2 * ks + 1][3]));
    }
    f32x4 qs = (f32x4){0.f, 0.f, 0.f, 0.f}, pt = qs;
    qs = __builtin_amdgcn_mfma_f32_16x16x32_bf16(QF[0], SB[0], qs, 0, 0, 0);
    qs = __builtin_amdgcn_mfma_f32_16x16x32_bf16(QF[1], SB[1], qs, 0, 0, 0);
    pt = __builtin_amdgcn_mfma_f32_16x16x32_bf16(KF[0], QF[0], pt, 0, 0, 0);
    pt = __builtin_amdgcn_mfma_f32_16x16x32_bf16(KF[1], QF[1], pt, 0, 0, 0);
#pragma unroll
    for (int r = 0; r < 4; ++r) if (4 * q + r > n) pt[r] = 0.f;
    const bf16x8 PF = mkfrag(cvtpk(pt[0], pt[1]), cvtpk(pt[2], pt[3]), 0u, 0u);
    const float4 v4 = *(const float4*)(bf + 3456 + (wl * 16 + n) * 20 + 4 * q);
    const bf16x8 VF = mkfrag(cvtpk(v4.x, v4.y), cvtpk(v4.z, v4.w), 0u, 0u);
    const f32x4 o = __builtin_amdgcn_mfma_f32_16x16x32_bf16(PF, VF, qs, 0, 0, 0);
#pragma unroll
    for (int r = 0; r < 4; ++r) obuf[(size_t)(st * 16 + 4 * q + r) * 2048] = o[r];
#pragma unroll
    for (int kt = 0; kt < 4; ++kt) {
      const float4 k4 = *(const float4*)(bf + 2176 + (16 * kt + n) * 20 + 4 * q);
      const bf16x8 KTF = mkfrag(cvtpk(k4.x, k4.y), cvtpk(k4.z, k4.w), 0u, 0u);
      St[kt] = __builtin_amdgcn_mfma_f32_16x16x32_bf16(KTF, VF, St[kt], 0, 0, 0);
      if (MODE == 1) {
        const float4 p4 = *(const float4*)(bf + 4736 + 16 * kt + 4 * q);
        St[kt][0] *= p4.x; St[kt][1] *= p4.y; St[kt][2] *= p4.z; St[kt][3] *= p4.w;
      } else {
        St[kt][0] *= g16; St[kt][1] *= g16; St[kt][2] *= g16; St[kt][3] *= g16;
      }
    }
    if (st + 1 < NST) { if (SL == 0) LSTOREM(bn, 1); else LSTOREM(bn, 0); }
    __syncthreads();
  };
#pragma unroll 1
  for (int st = 0; st + 1 < NST; st += 2) { stage(st, 0); stage(st + 1, 1); }
  stage(NST - 1, 0);
#undef GLOADM
#undef LSTOREM
  float* so = p.out + (MODE == 1 ? O_PG : O_PR) + ((size_t)(l * 4 + b) * 4 + h) * 64 * 128 + col0 + n;
#pragma unroll
  for (int kt = 0; kt < 4; ++kt)
#pragma unroll
    for (int r = 0; r < 4; ++r) so[(size_t)(16 * kt + 4 * q + r) * 128] = St[kt][r];
}

template <int MODE>
__device__ __forceinline__ void scan_sample(CP& p, int l, int item, int wv) {
  extern __shared__ __attribute__((aligned(16))) unsigned char smem_raw[];
  constexpr int DK = MODE == 0 ? 128 : 64;
  constexpr int NP = MODE == 0 ? 2 : 1;
  constexpr int RK = DK / NP;
  constexpr int E2 = RK / 2;
  constexpr int TPH = 128 * NP;
  constexpr int QOFF = MODE == 0 ? P_QA : (MODE == 1 ? P_QC : P_QD);
  constexpr int KOFF = MODE == 0 ? P_KA : (MODE == 1 ? P_KC : P_KD);
  constexpr int OB = MODE == 0 ? 0 : (MODE == 1 ? 1024 : 1536);
  const int tid = opaque_tid(wv);
  const int kp = NP == 2 ? (tid & 1) : 0;
  const int col = NP == 2 ? (tid >> 1) : tid;
  const int hl = col >> 7, v = col & 127;
  const int b = NP == 2 ? (item >> 1) : item;
  const int h = NP == 2 ? (item & 1) * 2 + hl : hl;
  const int ht = tid - hl * TPH;
  float* sm = (float*)smem_raw + hl * (12 * DK + 16);
  float* sq = sm; float* sk = sm + 4 * DK; float* sal = sm + 8 * DK; float* ssc = sm + 12 * DK;
  const size_t soff = ((size_t)(l * 128 + b) * 4 + h) * DK * 128 + (size_t)(kp * RK) * 128 + v;
  const float* st_in = (MODE == 0 ? p.in[2] : (MODE == 1 ? p.in[6] : p.in[7])) + soff;
  float* st_out = p.out + (MODE == 0 ? O_SD : (MODE == 1 ? O_SG : O_SR)) + soff;
  const float* prep = (const float*)(p.ws + WS_PREP) + (size_t)(NPR + b * 4) * PREP_LD;
  const float* proj = (const float*)(p.ws + WS_PROJ) + (size_t)(NPR + b * 4) * LDP;
  float* obuf = (float*)(p.ws + WS_OBUF) + (size_t)(NPR + b * 4) * 2048 + OB + h * 128 + v;
  f2 s[E2];
#pragma unroll
  for (int e = 0; e < E2; ++e) { s[e].x = st_in[(size_t)(2 * e) * 128]; s[e].y = st_in[(size_t)(2 * e + 1) * 128]; }
  for (int idx = ht; idx < 4 * DK; idx += TPH) {
    const int t = idx / DK, c = idx % DK;
    sq[idx] = prep[(size_t)t * PREP_LD + QOFF + h * DK + c];
    sk[idx] = prep[(size_t)t * PREP_LD + KOFF + h * DK + c];
    if (MODE == 1) sal[idx] = prep[(size_t)t * PREP_LD + P_AC + h * 64 + c];
  }
  if (MODE == 0 && ht < 8) ssc[ht] = prep[(size_t)(ht & 3) * PREP_LD + (ht < 4 ? P_AB : P_AB + 4) + h];
  float vv[4];
#pragma unroll
  for (int t = 0; t < 4; ++t)
    vv[t] = MODE == 0 ? prep[(size_t)t * PREP_LD + P_VA + h * 128 + v] : proj[(size_t)t * LDP + (MODE == 1 ? C_VC : C_VD) + h * 128 + v];
  const float gamma = 1.f - exp2f(-5.f - (float)h);
  __syncthreads();
#pragma unroll
  for (int t = 0; t < 4; ++t) {
    const float* kt = sk + t * DK + kp * RK; const float* qt = sq + t * DK + kp * RK;
    if (MODE == 0) {
      f2 ra0 = (f2){0.f, 0.f}, ra1 = ra0;
#pragma unroll
      for (int e = 0; e < E2; e += 2) {
        const float4 k4 = *(const float4*)(kt + 2 * e);
        ra0 = ((f2){k4.x, k4.y}) * s[e] + ra0; ra1 = ((f2){k4.z, k4.w}) * s[e + 1] + ra1;
      }
      float r = (ra0.x + ra0.y) + (ra1.x + ra1.y);
      r += dpp_f<0xB1>(r);
      const float a = ssc[t], be = ssc[4 + t];
      const float dd = be * (vv[t] - a * r);
      const f2 a2 = (f2){a, a}, d2 = (f2){dd, dd};
#pragma unroll
      for (int e = 0; e < E2; e += 2) {
        const float4 k4 = *(const float4*)(kt + 2 * e);
        s[e] = ((f2){k4.x, k4.y}) * d2 + a2 * s[e]; s[e + 1] = ((f2){k4.z, k4.w}) * d2 + a2 * s[e + 1];
      }
    } else if (MODE == 1) {
      const f2 v2 = (f2){vv[t], vv[t]};
#pragma unroll
      for (int e = 0; e < E2; e += 2) {
        const float4 k4 = *(const float4*)(kt + 2 * e);
        const float4 a4 = *(const float4*)(sal + t * DK + 2 * e);
        s[e] = ((f2){k4.x, k4.y}) * v2 + ((f2){a4.x, a4.y}) * s[e]; s[e + 1] = ((f2){k4.z, k4.w}) * v2 + ((f2){a4.z, a4.w}) * s[e + 1];
      }
    } else {
      const f2 v2 = (f2){vv[t], vv[t]}, g2 = (f2){gamma, gamma};
#pragma unroll
      for (int e = 0; e < E2; e += 2) {
        const float4 k4 = *(const float4*)(kt + 2 * e);
        s[e] = ((f2){k4.x, k4.y}) * v2 + g2 * s[e]; s[e + 1] = ((f2){k4.z, k4.w}) * v2 + g2 * s[e + 1];
      }
    }
    f2 oa0 = (f2){0.f, 0.f}, oa1 = oa0;
#pragma unroll
    for (int e = 0; e < E2; e += 2) {
      const float4 q4 = *(const float4*)(qt + 2 * e);
      oa0 = ((f2){q4.x, q4.y}) * s[e] + oa0; oa1 = ((f2){q4.z, q4.w}) * s[e + 1] + oa1;
    }
    float o = (oa0.x + oa0.y) + (oa1.x + oa1.y);
    if (NP == 2) o += dpp_f<0xB1>(o);
    if (kp == 0) obuf[(size_t)t * 2048] = o;
  }
#pragma unroll
  for (int e = 0; e < E2; ++e) { st_out[(size_t)(2 * e) * 128] = s[e].x; st_out[(size_t)(2 * e + 1) * 128] = s[e].y; }
  __syncthreads();
}

__device__ __forceinline__ void scan_lru_prompt(CP& p, int l, int b, int cgp, int wv) {
  extern __shared__ __attribute__((aligned(16))) unsigned char smem_raw[];
  float* sA = (float*)smem_raw; float* sB = sA + 512;
  const int tid = opaque_tid(wv);
  const int ch = tid & 31, seg = tid >> 5, c = cgp * 32 + ch;
  const float* prep = (const float*)(p.ws + WS_PREP) + (size_t)(b * LP + seg * 129) * PREP_LD + c;
  float* obuf = (float*)(p.ws + WS_OBUF) + (size_t)(b * LP + seg * 129) * 2048 + 512 + c;
  float A = 1.f, B = 0.f;
#pragma unroll 1
  for (int t0 = 0; t0 < 129; t0 += 43) {
    float av[43], bv[43];
#pragma unroll
    for (int i = 0; i < 43; ++i) { av[i] = prep[(size_t)(t0 + i) * PREP_LD + P_LA]; bv[i] = prep[(size_t)(t0 + i) * PREP_LD + P_LB]; }
#pragma unroll
    for (int i = 0; i < 43; ++i) { B = av[i] * B + bv[i]; A *= av[i]; }
  }
  sA[seg * 32 + ch] = A; sB[seg * 32 + ch] = B;
  __syncthreads();
  float h = 0.f;
  for (int s2 = 0; s2 < seg; ++s2) h = sA[s2 * 32 + ch] * h + sB[s2 * 32 + ch];
#pragma unroll 1
  for (int t0 = 0; t0 < 129; t0 += 43) {
    float av[43], bv[43];
#pragma unroll
    for (int i = 0; i < 43; ++i) { av[i] = prep[(size_t)(t0 + i) * PREP_LD + P_LA]; bv[i] = prep[(size_t)(t0 + i) * PREP_LD + P_LB]; }
#pragma unroll
    for (int i = 0; i < 43; ++i) { h = av[i] * h + bv[i]; obuf[(size_t)(t0 + i) * 2048] = h; }
  }
  if (seg == 15) p.out[O_PL + (size_t)(l * 4 + b) * 512 + c] = h;
  __syncthreads();
}

__device__ __forceinline__ void scan_lru_sample(CP& p, int l, int b, int wv) {
  const int c = opaque_tid(wv);
  const float* prep = (const float*)(p.ws + WS_PREP) + (size_t)(NPR + b * 4) * PREP_LD;
  float* obuf = (float*)(p.ws + WS_OBUF) + (size_t)(NPR + b * 4) * 2048 + 512 + c;
  float h = p.in[4][(size_t)(l * 128 + b) * 512 + c];
#pragma unroll
  for (int t = 0; t < 4; ++t) { h = prep[(size_t)t * PREP_LD + P_LA + c] * h + prep[(size_t)t * PREP_LD + P_LB + c]; obuf[(size_t)t * 2048] = h; }
  p.out[O_SL + (size_t)(l * 128 + b) * 512 + c] = h;
}

__device__ __forceinline__ void scan_item2(CP& p, int l, int k, int wv) {
  if (k < 64) scan_lru_prompt(p, l, k >> 4, k & 15, wv);
  else if (k < 320) scan_sample<0>(p, l, k - 64, wv);
  else if (k < 448) scan_sample<1>(p, l, k - 320, wv);
  else if (k < 576) scan_sample<2>(p, l, k - 448, wv);
  else scan_lru_sample(p, l, k - 576, wv);
}

__device__ __forceinline__ void phase_scan(CP& p, int l, int wv) {
  extern __shared__ __attribute__((aligned(16))) unsigned char smem_raw[];
  float* sm = (float*)smem_raw;
  const int G = gridDim.x;
  const int tid = opaque_tid(wv);
  const int role = tid >> 8, rt = tid & 255;
#pragma unroll 1
  for (int it = blockIdx.x; it < 32; it += G) {
    if (role == 0) scan_prompt_delta_mfma(p, l, it >> 1, it & 1, sm, rt);
    else { for (int i = 0; i < NST + 1; ++i) __syncthreads(); }
    __syncthreads();
  }
#pragma unroll 1
  for (int it = blockIdx.x < 32 ? blockIdx.x + ((32 + G - 1 - blockIdx.x) / G) * G : blockIdx.x; it < 64; it += G) {
    const int i2 = it - 32;
    if (role == 0) scan_prompt_mfma<1>(p, l, i2 >> 1, i2 & 1, sm, rt);
    else scan_prompt_mfma<2>(p, l, i2 >> 1, i2 & 1, sm + 10240, rt);
    __syncthreads();
  }
  if (G >= 128) {
#pragma unroll 1
    for (int k = (int)blockIdx.x - 64; k >= 0 && k < 704; k += G - 64) scan_item2(p, l, k, wv);
    __syncthreads();
  } else {
#pragma unroll 1
    for (int k = blockIdx.x; k < 704; k += G) scan_item2(p, l, k, wv);
    __syncthreads();
  }
  __syncthreads();
}

__device__ __forceinline__ void phase_post(CP& p, int l, int wv) {
  const int tid = opaque_tid(wv), lane = tid & 63, w = tid >> 6;
  const float* obuf = (const float*)(p.ws + WS_OBUF);
  const float* proj = (const float*)(p.ws + WS_PROJ);
  unsigned* mix = (unsigned*)(p.ws + WS_MIX);
  const unsigned short* gb16 = (const unsigned short*)(p.ws + WS_GB16);
  const float2 na = *(const float2*)(p.in[14] + l * 128 + lane * 2);
  const float2 nc = *(const float2*)(p.in[24] + l * 128 + lane * 2);
  for (int r = blockIdx.x * 8 + w; r < MROWS; r += gridDim.x * 8) {
#pragma unroll 4
    for (int seg = 0; seg < 16; ++seg) {
      float2 x = *(const float2*)(obuf + (size_t)r * 2048 + seg * 128 + lane * 2);
      const int ca = C_GATE + seg * 128 + lane * 2;
      float sgx, sgy;
      if (ca >= GCOL0) { const unsigned u = *(const unsigned*)(gb16 + (size_t)r * 2048 + (ca - GCOL0)); sgx = siluf_(__uint_as_float(u << 16)); sgy = siluf_(__uint_as_float(u & 0xffff0000u)); }
      else { const float2 g = *(const float2*)(proj + (size_t)r * LDP + ca); sgx = siluf_(g.x); sgy = siluf_(g.y); }
      const int ty = seg >> 2;
      if (ty != 1) {
        const float ss = wave_allsum(x.x * x.x + x.y * x.y);
        const float sc = __builtin_amdgcn_rsqf(ss * (1.f / 128.f) + 1e-6f);
        x.x *= sc; x.y *= sc;
        if (ty == 0) { x.x *= na.x; x.y *= na.y; }
        else if (ty == 2) { x.x *= nc.x; x.y *= nc.y; }
      }
      mix[(size_t)r * 1024 + seg * 64 + lane] = pack2(x.x * sgx, x.y * sgy);
    }
  }
}

__device__ __forceinline__ void phase_final(CP& p, int wv) {
  const int tid = opaque_tid(wv), lane = tid & 63, w = tid >> 6;
  const float* H = (const float*)(p.ws + WS_H);
  const float4* fw = (const float4*)p.in[26];
  for (int r = blockIdx.x * 8 + w; r < MROWS; r += gridDim.x * 8) {
    float* dst;
    if (r < NPR) { const int b = r / LP, t = r % LP; if (t < 16) continue; dst = p.out + O_YP + ((size_t)b * 2048 + (t - 16)) * D; }
    else dst = p.out + O_YS + (size_t)(r - NPR) * D;
    const float4* src = (const float4*)(H + (size_t)r * D);
    float4 v[8]; float ss = 0.f;
#pragma unroll
    for (int i = 0; i < 8; ++i) v[i] = src[lane + 64 * i];
    if (r >= 8192) {
      const float* pb = (const float*)(p.ws + WS_PB) + ((size_t)(((r >> 8) - 32) * 8) * 8) * 65536 + (size_t)(r & 255) * 256 + lane * 4;
#pragma unroll
      for (int i = 0; i < 8; ++i)
#pragma unroll
        for (int ch = 0; ch < 8; ++ch) { const float4 a = *(const float4*)(pb + (size_t)(i * 8 + ch) * 65536); v[i].x += a.x; v[i].y += a.y; v[i].z += a.z; v[i].w += a.w; }
    }
#pragma unroll
    for (int i = 0; i < 8; ++i) ss += v[i].x * v[i].x + v[i].y * v[i].y + v[i].z * v[i].z + v[i].w * v[i].w;
    ss = wave_allsum(ss);
    const float sc = __builtin_amdgcn_rsqf(ss * (1.f / 2048.f) + 1e-6f);
#pragma unroll
    for (int i = 0; i < 8; ++i) {
      const float4 wv = fw[lane + 64 * i];
      ((float4*)dst)[lane + 64 * i] = make_float4(v[i].x * sc * wv.x, v[i].y * sc * wv.y, v[i].z * sc * wv.z, v[i].w * sc * wv.w);
    }
  }
}

#define XB_TMO      128
#define XB_XCNT(j)  (256  + 64 * (j))
#define XB_XSUB(j)  (1280 + 64 * (j))
#define XB_XGEN(j)  (2304 + 64 * (j))
#define XB_TOP      3328
#define XB_TOPGEN   3392
#define XCD_BAR_WORDS 3456
#define XB_SPIN_CAP (1u << 22)
#define LAS __attribute__((address_space(3)))
__device__ __forceinline__ unsigned xb_ld(unsigned* p)              { return __hip_atomic_load(p, __ATOMIC_RELAXED, __HIP_MEMORY_SCOPE_AGENT); }
__device__ __forceinline__ unsigned xb_add(unsigned* p, unsigned v) { return __hip_atomic_fetch_add(p, v, __ATOMIC_RELAXED, __HIP_MEMORY_SCOPE_AGENT); }
__device__ __forceinline__ unsigned xb_xcc_id() { return (unsigned)__builtin_amdgcn_s_getreg((3 << 11) | 20) & 0xFu; }
#define XB_SPIN(cond, bar) do { unsigned _sp = 0; while (cond) { __builtin_amdgcn_s_sleep(1); \
    if ((++_sp & 255u) == 0u) { if (xb_ld(&(bar)[XB_TMO])) break; if (_sp > XB_SPIN_CAP) { atomicAdd(&(bar)[XB_TMO], 1u); break; } } } } while (0)
__device__ __forceinline__ void xcd_barrier_complete(unsigned* bar, unsigned x, unsigned& nloc, unsigned& nx) {
  const unsigned G = gridDim.x;
  unsigned sum, cnt, mine, sp = 0u;
  for (;;) {
    sum = 0u; cnt = 0u; mine = 0u;
#pragma unroll
    for (unsigned j = 0; j < 16; ++j) { const unsigned c = xb_ld(&bar[XB_XCNT(j)]); sum += c; cnt += (c > 0u) ? 1u : 0u; mine = (j == x) ? c : mine; }
    if (sum == G) break;
    __builtin_amdgcn_s_sleep(1);
    if ((++sp & 255u) == 0u) { if (xb_ld(&bar[XB_TMO])) break; if (sp > XB_SPIN_CAP) { atomicAdd(&bar[XB_TMO], 1u); break; } }
  }
  nloc = mine > 0u ? mine : 1u; nx = cnt > 0u ? cnt : 1u;
}
__device__ __forceinline__ void fast_grid_sync(unsigned* bar, int wv) {
  extern __shared__ __attribute__((aligned(16))) unsigned char smem_raw[];
  asm volatile("s_waitcnt vmcnt(0)" ::: "memory");
  __syncthreads();
  if (wv == 0) {
    if (opaque_tid(wv) == 0) {
      volatile LAS unsigned* st = (volatile LAS unsigned*)(smem_raw + 131072);
      __builtin_amdgcn_s_waitcnt(0);
      const unsigned x = xb_xcc_id();
      unsigned nloc = st[0], nx = st[1];
      if (nloc == 0u) { xcd_barrier_complete(bar, x, nloc, nx); st[0] = nloc; st[1] = nx; }
      const unsigned old = xb_add(&bar[XB_XSUB(x)], 1u);
      const unsigned gen = old / nloc;
      if (old + 1u == (gen + 1u) * nloc) {
        __builtin_amdgcn_fence(__ATOMIC_RELEASE, "agent");
        asm volatile("s_waitcnt vmcnt(0)" ::: "memory");
        const unsigned og = xb_add(&bar[XB_TOP], 1u);
        const unsigned tg = og / nx;
        if (og + 1u == (tg + 1u) * nx) xb_add(&bar[XB_TOPGEN], 1u);
        else XB_SPIN(xb_ld(&bar[XB_TOPGEN]) == tg, bar);
        __builtin_amdgcn_fence(__ATOMIC_ACQUIRE, "agent");
        xb_add(&bar[XB_XGEN(x)], 1u);
        asm volatile("s_waitcnt vmcnt(0)" ::: "memory");
      } else {
        XB_SPIN(xb_ld(&bar[XB_XGEN(x)]) == gen, bar);
        __builtin_amdgcn_fence(__ATOMIC_ACQUIRE, "agent");
        asm volatile("s_waitcnt vmcnt(0)" ::: "memory");
      }
    }
  }
  __syncthreads();
}

__global__ void __launch_bounds__(NTHR) mega(P p_) {
  cg::grid_group grid = cg::this_grid();
  const int wv = __builtin_amdgcn_readfirstlane((int)(threadIdx.x >> 6));
#define GSYNC(j_) fast_grid_sync((unsigned*)((*getp()).ws + WS_BAR), wv)
  { extern __shared__ __attribute__((aligned(16))) unsigned char smem_raw[];
    if (wv == 0 && opaque_tid(wv) == 0) { volatile LAS unsigned* st = (volatile LAS unsigned*)(smem_raw + 131072); st[0] = 0u; st[1] = 0u;
      (void)xb_add(&((unsigned*)((*getp()).ws + WS_BAR))[XB_XCNT(xb_xcc_id())], 1u); }
    __syncthreads(); }
  phase_convert(*getp(), wv);
  if ((*getp()).pad != 0) grid.sync();
  GSYNC(0);
#pragma unroll 1
  for (int l = 0; l < 4; ++l) {
    phase_norm(*getp(), wv, l > 0);
    GSYNC(1);
    { CP& p = *getp();
      phase_gemm<0>((const bf16*)(p.ws + WS_XN), (const bf16*)(p.ws + WS_WTIN) + (size_t)l * LDW * 2048, (float*)(p.ws + WS_PROJ), p.mpad, p.ldp, wv, p.ldq, (unsigned short*)(p.ws + WS_GB16)); }
    {
      const int G_ = gridDim.x, nt4 = 875 - 3 * G_;
      if (l < 3 && G_ == 256 && (int)blockIdx.x >= nt4) convert_weights(*getp(), wv, (l + 1) * CV_TL, (l + 2) * CV_TL, (int)blockIdx.x - nt4, G_ - nt4);
      else if (l < 3 && G_ != 256) convert_weights(*getp(), wv, (l + 1) * CV_TL, (l + 2) * CV_TL, blockIdx.x, G_); }
    GSYNC(2);
    phase_prep(*getp(), l, wv);
    GSYNC(3);
    phase_prep2(*getp(), wv);
    GSYNC(4);
    phase_scan(*getp(), l, wv);
    GSYNC(5);
    phase_post(*getp(), l, wv);
    GSYNC(6);
    { CP& p = *getp();
      phase_gemm_out((const bf16*)(p.ws + WS_MIX), (const bf16*)(p.ws + WS_WTOUT) + (size_t)l * 2048 * 2048, (float*)(p.ws + WS_H), (float*)(p.ws + WS_PB), p.mpad, p.dm, wv); }
    GSYNC(7);
  }
  phase_final(*getp(), wv);
}

#undef GSYNC
extern "C" void kernel_launch(void* const* d_in, const int* in_sizes, int n_in, void* d_out, int out_size, void* d_ws, size_t ws_size,
                              hipStream_t stream) {
  static int grid = 0;
  if (grid == 0) {
    int dev = 0, cus = 0, per_cu = 0;
    hipGetDevice(&dev);
    hipDeviceGetAttribute(&cus, hipDeviceAttributeMultiprocessorCount, dev);
    hipFuncSetAttribute((const void*)mega, hipFuncAttributeMaxDynamicSharedMemorySize, LDS_BYTES);
    hipOccupancyMaxActiveBlocksPerMultiprocessor(&per_cu, (const void*)mega, NTHR, LDS_BYTES);
    if (per_cu < 1) per_cu = 1;
    if (per_cu > 1) per_cu = 1;
    grid = cus * per_cu;
    if (ws_size < WS_END) { fprintf(stderr, "workspace too small: %zu < %zu\n", ws_size, (size_t)WS_END); }
  }
  P p{};
  for (int i = 0; i < 27; ++i) p.in[i] = (const float*)d_in[i];
  p.out = (float*)d_out;
  p.ws = (unsigned char*)d_ws;
  p.mpad = MPAD; p.ldp = LDW; p.dm = D; p.pad = 0; p.ldq = LDP; p.pad2 = 0;
  (void)hipMemsetAsync((unsigned char*)d_ws + WS_BAR, 0, 16384, stream);
  void* args[] = {&p};
  hipError_t e = hipLaunchCooperativeKernel((const void*)mega, dim3(grid), dim3(NTHR), args, LDS_BYTES, stream);
  if (e != hipSuccess) fprintf(stderr, "cooperative launch failed: %s (grid %d)\n", hipGetErrorString(e), grid);
}
```

```cpp
#include <hip/hip_runtime.h>
#include <hip/hip_bf16.h>
#include <hip/hip_cooperative_groups.h>
#include <cstdio>
namespace cg = cooperative_groups;

using bf16 = __hip_bfloat16;
using bf16x8 = __attribute__((ext_vector_type(8))) short;
using f32x4 = __attribute__((ext_vector_type(4))) float;

constexpr int D = 2048;
constexpr int LP = 2064;
constexpr int NPR = 4 * LP;
constexpr int NSR = 512;
constexpr int MROWS = NPR + NSR;
constexpr int MPAD = 8960;
constexpr int INW = 6168;
constexpr int LDW = 6400;
constexpr int LDP = 4352;
constexpr int GCOL0 = 4352;
constexpr int NTHR = 512;
constexpr int LDS_BYTES = 131072 + 64;

constexpr int C_ALPHA = 1536, C_BETA = 1540, C_XB = 1544, C_QC = 2056, C_KC = 2312, C_VC = 2568, C_RC = 3080,
              C_QD = 3096, C_KD = 3352, C_VD = 3608, C_GATE = 4120;
constexpr int P_QA = 0, P_KA = 512, P_VA = 1024, P_AB = 1536, P_LA = 1544, P_LB = 2056, P_QC = 2568, P_KC = 2824,
              P_AC = 3080, P_QD = 3336, P_KD = 3592, P_WA = 3848, P_KH = 4360, P_GC = 4872, P_DM = 4880, PREP_LD = 4944;

constexpr size_t O_YP = 0;
constexpr size_t O_YS = O_YP + (size_t)4 * 2048 * 2048;
constexpr size_t O_PD = O_YS + (size_t)128 * 4 * 2048;
constexpr size_t O_PDC = O_PD + (size_t)4 * 4 * 4 * 128 * 128;
constexpr size_t O_PL = O_PDC + (size_t)4 * 4 * 3 * 1536;
constexpr size_t O_PLC = O_PL + (size_t)4 * 4 * 512;
constexpr size_t O_PG = O_PLC + (size_t)4 * 4 * 3 * 512;
constexpr size_t O_PR = O_PG + (size_t)4 * 4 * 4 * 64 * 128;
constexpr size_t O_SD = O_PR + (size_t)4 * 4 * 4 * 64 * 128;
constexpr size_t O_SDC = O_SD + (size_t)4 * 128 * 4 * 128 * 128;
constexpr size_t O_SL = O_SDC + (size_t)4 * 128 * 3 * 1536;
constexpr size_t O_SLC = O_SL + (size_t)4 * 128 * 512;
constexpr size_t O_SG = O_SLC + (size_t)4 * 128 * 3 * 512;
constexpr size_t O_SR = O_SG + (size_t)4 * 128 * 4 * 64 * 128;

constexpr size_t WS_WTIN = 0;
constexpr size_t WS_WTOUT = WS_WTIN + (size_t)4 * LDW * 2048 * 2;
constexpr size_t WS_H = WS_WTOUT + (size_t)4 * 2048 * 2048 * 2;
constexpr size_t WS_XN = WS_H + (size_t)MPAD * 2048 * 4;
constexpr size_t WS_PROJ = WS_XN + (size_t)MPAD * 2048 * 2;
constexpr size_t WS_PREP = WS_PROJ + (size_t)MPAD * LDP * 4;
constexpr size_t WS_OBUF = WS_PREP + (size_t)MROWS * PREP_LD * 4;
constexpr size_t WS_MIX = WS_XN;
constexpr size_t WS_WTG = WS_OBUF + (size_t)MROWS * 2048 * 4;
constexpr size_t WS_GDEC = WS_WTG + (size_t)4 * 4 * 2 * 128 * 128 * 2;
constexpr size_t WS_BAR = WS_GDEC + (size_t)(MROWS / 16) * 256 * 4;
constexpr size_t WS_PB = WS_BAR + 16384;
constexpr size_t WS_GB16 = WS_PB + (size_t)24 * 8 * 65536 * 4;
constexpr size_t WS_END = WS_GB16 + (size_t)MPAD * 2048 * 2;

struct P { const float* in[27]; float* out; unsigned char* ws; int mpad, ldp, dm, pad, ldq, pad2; };
typedef const __attribute__((address_space(4))) P CP;
__device__ __forceinline__ CP* getp() { CP* pp = (CP*)__builtin_amdgcn_kernarg_segment_ptr(); asm volatile("" : "+s"(pp)); return pp; }

__device__ __forceinline__ unsigned short f2bf(float f) {
  unsigned u = __float_as_uint(f);
  u += 0x7fffu + ((u >> 16) & 1u);
  return (unsigned short)(u >> 16);
}
typedef float cvf2_t __attribute__((ext_vector_type(2)));
typedef __bf16 cvb2_t __attribute__((ext_vector_type(2)));
__device__ __forceinline__ unsigned cvtpk(float lo, float hi) { cvf2_t v = {lo, hi}; return __builtin_bit_cast(unsigned, __builtin_convertvector(v, cvb2_t)); }
__device__ __forceinline__ unsigned pack2(float a, float b) { return cvtpk(a, b); }
__device__ __forceinline__ float sigmoidf_(float x) { return __builtin_amdgcn_rcpf(1.f + __expf(-x)); }
__device__ __forceinline__ float siluf_(float x) { return x * __builtin_amdgcn_rcpf(1.f + __expf(-x)); }
__device__ __forceinline__ float softplusf_(float x) {
  const float e = __expf(fminf(x, 15.f));
  const float mid = __logf(1.f + e);
  return x > 15.f ? x : (x < -6.f ? e * (1.f - 0.5f * e) : mid);
}
template <int CTRL> __device__ __forceinline__ float dpp_f(float x) {
  return __builtin_bit_cast(float, __builtin_amdgcn_update_dpp(0, __builtin_bit_cast(int, x), CTRL, 0xf, 0xf, true));
}

typedef __attribute__((ext_vector_type(4))) unsigned u32x4;
__device__ __forceinline__ bf16x8 mkfrag(unsigned a, unsigned b, unsigned c, unsigned d) { u32x4 t = {a, b, c, d}; return __builtin_bit_cast(bf16x8, t); }
__device__ __forceinline__ float row16_allsum(float x) {
  x += dpp_f<0x128>(x);
  x += dpp_f<0x124>(x);
  x += dpp_f<0x122>(x);
  x += dpp_f<0x121>(x);
  return x;
}
__device__ __forceinline__ float wave_allsum(float x) {
  x = row16_allsum(x);
  x += __builtin_bit_cast(float, __builtin_amdgcn_update_dpp(0, __builtin_bit_cast(int, x), 0x142, 0xa, 0xf, false));
  x += __builtin_bit_cast(float, __builtin_amdgcn_update_dpp(0, __builtin_bit_cast(int, x), 0x143, 0xc, 0xf, false));
  return __builtin_bit_cast(float, __builtin_amdgcn_readlane(__builtin_bit_cast(int, x), 63));
}

__device__ __forceinline__ int opaque_tid(int wv) { unsigned m = ~0u; asm volatile("" : "+s"(m)); int t = wv * 64 + (int)__builtin_amdgcn_mbcnt_hi(m, __builtin_amdgcn_mbcnt_lo(m, 0u)); asm volatile("" : "+v"(t)); return t; }

constexpr int CV_TIN = 32 * 100, CV_TOUT = 32 * 32, CV_TL = CV_TIN + CV_TOUT;
__device__ __forceinline__ void convert_weights(CP& p, int wv, int t_lo, int t_hi, int bidx, int nb) {
  extern __shared__ __attribute__((aligned(16))) unsigned char smem_raw[];
  float* sm = (float*)smem_raw;
  const int tid = opaque_tid(wv);
  bf16* wtin = (bf16*)(p.ws + WS_WTIN);
  bf16* wtout = (bf16*)(p.ws + WS_WTOUT);
  constexpr int TIN = CV_TIN, TL = CV_TL;
  {
    const int kk0 = tid >> 4, n4 = (tid & 15) * 4;
    const int nn = tid >> 3, k8 = (tid & 7) * 8;
    float4 va = make_float4(0.f, 0.f, 0.f, 0.f), vb = va; float sa = 1.f, sb = 1.f;
#define CV_DECODE(t_) \
    const int l_ = (t_) / TL; int r_ = (t_) % TL; const float* src_; int nsrc_, kt_, nt_; const float* nw_; unsigned short* dst_; \
    if (r_ < TIN) { kt_ = r_ / 100; nt_ = r_ % 100; src_ = p.in[10] + (size_t)l_ * 2048 * INW; nsrc_ = INW; \
                    dst_ = (unsigned short*)(wtin + (size_t)l_ * LDW * 2048); nw_ = p.in[9] + l_ * 2048; } \
    else { r_ -= TIN; kt_ = r_ / 32; nt_ = r_ % 32; src_ = p.in[25] + (size_t)l_ * 2048 * 2048; nsrc_ = 2048; \
           dst_ = (unsigned short*)(wtout + (size_t)l_ * 2048 * 2048); nw_ = nullptr; }
#define CV_LOAD(t_) do { CV_DECODE(t_) (void)dst_; \
      const int n_ = nt_ * 64 + n4, ka_ = kt_ * 64 + kk0, kb_ = ka_ + 32; \
      va = make_float4(0.f, 0.f, 0.f, 0.f); vb = va; \
      if (n_ < nsrc_) { va = *(const float4*)(src_ + (size_t)ka_ * nsrc_ + n_); vb = *(const float4*)(src_ + (size_t)kb_ * nsrc_ + n_); } \
      sa = nw_ ? nw_[ka_] : 1.f; sb = nw_ ? nw_[kb_] : 1.f; } while (0)
    int t = t_lo + bidx;
    if (t < t_hi) CV_LOAD(t);
    int cur = 0;
    for (; t < t_hi; t += nb) {
      float* sb_ = sm + cur * (64 * 65);
      sb_[kk0 * 65 + n4 + 0] = va.x * sa; sb_[kk0 * 65 + n4 + 1] = va.y * sa; sb_[kk0 * 65 + n4 + 2] = va.z * sa; sb_[kk0 * 65 + n4 + 3] = va.w * sa;
      sb_[(kk0 + 32) * 65 + n4 + 0] = vb.x * sb; sb_[(kk0 + 32) * 65 + n4 + 1] = vb.y * sb; sb_[(kk0 + 32) * 65 + n4 + 2] = vb.z * sb; sb_[(kk0 + 32) * 65 + n4 + 3] = vb.w * sb;
      if (t + nb < t_hi) CV_LOAD(t + nb);
      __syncthreads();
      {
        CV_DECODE(t) (void)src_; (void)nsrc_; (void)nw_;
        uint4 o;
        o.x = pack2(sb_[(k8 + 0) * 65 + nn], sb_[(k8 + 1) * 65 + nn]);
        o.y = pack2(sb_[(k8 + 2) * 65 + nn], sb_[(k8 + 3) * 65 + nn]);
        o.z = pack2(sb_[(k8 + 4) * 65 + nn], sb_[(k8 + 5) * 65 + nn]);
        o.w = pack2(sb_[(k8 + 6) * 65 + nn], sb_[(k8 + 7) * 65 + nn]);
        *(uint4*)(dst_ + (size_t)(nt_ * 64 + nn) * 2048 + kt_ * 64 + k8) = o;
      }
      cur ^= 1;
    }
#undef CV_LOAD
#undef CV_DECODE
    __syncthreads();
  }
}

__device__ __forceinline__ void phase_convert(CP& p, int wv) {
  const int tid = opaque_tid(wv);
  convert_weights(p, wv, 0, CV_TL, blockIdx.x, gridDim.x);
  float* H = (float*)(p.ws + WS_H);
  const size_t gtid = (size_t)blockIdx.x * NTHR + tid, gsz = (size_t)gridDim.x * NTHR;
  for (size_t idx = gtid; idx < (size_t)MPAD * 512; idx += gsz) {
    const int r = (int)(idx >> 9), c4 = (int)(idx & 511) * 4;
    float4 v = make_float4(0.f, 0.f, 0.f, 0.f);
    if (r < NPR) { const int b = r / LP, t = r % LP;
      v = t < 16 ? *(const float4*)(p.in[8] + (size_t)t * D + c4) : *(const float4*)(p.in[0] + ((size_t)b * 2048 + (t - 16)) * D + c4); }
    else if (r < MROWS) v = *(const float4*)(p.in[1] + (size_t)(r - NPR) * D + c4);
    *(float4*)(H + (size_t)r * D + c4) = v;
  }
  {
    unsigned short* wtg = (unsigned short*)(p.ws + WS_WTG);
    for (size_t idx = gtid; idx < (size_t)4 * 4 * 2 * 128 * 128; idx += gsz) {
      const int c = (int)(idx & 127), d = (int)((idx >> 7) & 127), g = (int)((idx >> 14) & 1), blk = (int)((idx >> 15) & 3), l = (int)(idx >> 17);
      const float* srcg = (g == 0 ? p.in[17] : p.in[19]) + ((size_t)((l * 4 + blk) * 128 + c)) * 128 + d;
      wtg[idx] = f2bf(*srcg);
    }
  }
  unsigned* mixz = (unsigned*)(p.ws + WS_MIX + (size_t)MROWS * 2048 * 2);
  for (size_t idx = gtid; idx < (size_t)(MPAD - MROWS) * 1024; idx += gsz) mixz[idx] = 0u;
}

__device__ __forceinline__ void phase_norm(CP& p, int wv, int fix) {
  const int tid = opaque_tid(wv), lane = tid & 63, w = tid >> 6;
  float* H = (float*)(p.ws + WS_H);
  const float* PB = (const float*)(p.ws + WS_PB);
  unsigned short* XN = (unsigned short*)(p.ws + WS_XN);
  for (int r = blockIdx.x * 8 + w; r < MPAD; r += gridDim.x * 8) {
    uint2* dst = (uint2*)(XN + (size_t)r * D);
    if (r >= MROWS) {
#pragma unroll
      for (int i = 0; i < 8; ++i) dst[lane + 64 * i] = make_uint2(0u, 0u);
      continue;
    }
    float4* src = (float4*)(H + (size_t)r * D);
    float4 v[8]; float ss = 0.f;
#pragma unroll
    for (int i = 0; i < 8; ++i) v[i] = src[lane + 64 * i];
    if (fix && r >= 8192) {
      const float* pb = PB + ((size_t)(((r >> 8) - 32) * 8) * 8) * 65536 + (size_t)(r & 255) * 256 + lane * 4;
#pragma unroll
      for (int i = 0; i < 8; ++i) {
#pragma unroll
        for (int ch = 0; ch < 8; ++ch) { const float4 a = *(const float4*)(pb + (size_t)(i * 8 + ch) * 65536); v[i].x += a.x; v[i].y += a.y; v[i].z += a.z; v[i].w += a.w; }
        src[lane + 64 * i] = v[i];
      }
    }
#pragma unroll
    for (int i = 0; i < 8; ++i) ss += v[i].x * v[i].x + v[i].y * v[i].y + v[i].z * v[i].z + v[i].w * v[i].w;
    ss = wave_allsum(ss);
    const float sc = __builtin_amdgcn_rsqf(ss * (1.f / 2048.f) + 1e-6f);
#pragma unroll
    for (int i = 0; i < 8; ++i) dst[lane + 64 * i] = make_uint2(pack2(v[i].x * sc, v[i].y * sc), pack2(v[i].z * sc, v[i].w * sc));
  }
}

constexpr int BM = 256, BK = 64, HALF = 128, NXCD = 8, WGM = 8, HT = HALF * BK;
__device__ __forceinline__ int lds_byte(int r, int c) {
  int st = (r >> 4) * 2 + (c >> 5), rr = r & 15, cc = c & 31, ob = rr * 64 + cc * 2;
  return st * 1024 + (ob ^ (((ob >> 9) & 1) << 5));
}
__device__ __forceinline__ void stage_rc(int b, int& R, int& C) {
  int st = b / 1024, sb = b % 1024, swz = sb ^ (((sb >> 9) & 1) << 5);
  R = (st >> 1) * 16 + swz / 64; C = (st & 1) * 32 + (swz % 64) / 2;
}

template <int MODE> __device__ __forceinline__ void gemm_tile(const bf16*A,const bf16*Bt,float*C,int M,int N,int tile,int wv,int pmo,int pno,int kt0,int ntk,int ldc,int cpart,unsigned short*C16=nullptr){ constexpr int K=2048;
  extern __shared__ __attribute__((aligned(16))) bf16 shm[];
  const int tix = opaque_tid(wv);
  #define SA(b,h) (shm+((b)*2+(h))*HT)
  #define SB(b,h) (shm+(4+(b)*2+(h))*HT)
  unsigned soff0,soff1; {int _r,_c; stage_rc(tix*16,_r,_c); soff0=_r*K+_c; stage_rc(tix*16+8192,_r,_c); soff1=_r*K+_c;}
  #define STAGE(P,BASE,br,kt) do{const bf16* _gb=BASE+(long)(br)*K+(long)((kt)+kt0)*BK; \
      __builtin_amdgcn_global_load_lds((const unsigned*)(_gb+soff0),(unsigned*)((char*)(P)+tix*16),16,0,0); \
      __builtin_amdgcn_global_load_lds((const unsigned*)(_gb+soff1),(unsigned*)((char*)(P)+tix*16+8192),16,0,0);}while(0)
  #define LDA(dst,b,h) for(int m=0;m<4;++m)for(int k=0;k<2;++k) \
    dst[m][k]=*reinterpret_cast<const bf16x8*>((char*)SA(b,h)+lds_byte(wr*64+m*16+fr,k*32+fq*8))
  #define LDB(dst,b,h) for(int n=0;n<2;++n)for(int k=0;k<2;++k) \
    dst[n][k]=*reinterpret_cast<const bf16x8*>((char*)SB(b,h)+lds_byte(wc*32+n*16+fr,k*32+fq*8))
  #define MMA(ai,bj,At,Bt) do{__builtin_amdgcn_s_setprio(1); \
    for(int m=0;m<4;++m)for(int n=0;n<2;++n)for(int k=0;k<2;++k) \
      acc[ai][bj][m][n]=__builtin_amdgcn_mfma_f32_16x16x32_bf16(At[m][k],Bt[n][k],acc[ai][bj][m][n],0,0,0); \
    __builtin_amdgcn_s_setprio(0);}while(0)
  #define WAIT_V(n) asm volatile("s_waitcnt vmcnt(" #n ")":::"memory")
  #define WAIT_L(n) asm volatile("s_waitcnt lgkmcnt(" #n ")":::"memory")
  #define BAR __builtin_amdgcn_s_barrier()
  #define SCHED __builtin_amdgcn_sched_barrier(0)

  int nM=M/BM,nN=N/BM,nwg=nM*nN,wgid=tile;
  {int q=nwg/NXCD,r=nwg%NXCD,xcd=wgid%NXCD,off=wgid/NXCD;
   wgid=(xcd<r?xcd*(q+1):r*(q+1)+(xcd-r)*q)+off;}
  int nig=WGM*nN,gid=wgid/nig,fm=gid*WGM,gsz=min(nM-fm,WGM);
  int pm=fm+((wgid%nig)%gsz),pn=(wgid%nig)/gsz; if(pmo>=0){pm=pmo;pn=pno;} int brow=pm*BM,bcol=pn*BM;
  int wid=tix>>6,lane=tix&63,wr=wid>>2,wc=wid&3,fr=lane&15,fq=lane>>4;
  f32x4 acc[2][2][4][2]={};
  bf16x8 At[4][2],B0[2][2],B1[2][2];
  int nt=ntk;
  STAGE(SB(0,0),Bt,bcol,0); STAGE(SA(0,0),A,brow,0);
  STAGE(SB(0,1),Bt,bcol+HALF,0); STAGE(SA(0,1),A,brow+HALF,0);
  if(wr==1)BAR;
  WAIT_V(4); BAR;
  STAGE(SB(1,0),Bt,bcol,1); STAGE(SA(1,0),A,brow,1); STAGE(SB(1,1),Bt,bcol+HALF,1);
  WAIT_V(6); BAR;
  for(int t=0;t<nt-2;t+=2){
    LDB(B0,0,0); SCHED; LDA(At,0,0); STAGE(SA(1,1),A,brow+HALF,t+1);
    WAIT_L(8); BAR; WAIT_L(0); MMA(0,0,At,B0); BAR; SCHED;
    LDB(B1,0,1); STAGE(SB(0,0),Bt,bcol,t+2);
    BAR; WAIT_L(0); MMA(0,1,At,B1); BAR;
    LDA(At,0,1); STAGE(SA(0,0),A,brow,t+2);
    BAR; WAIT_L(0); MMA(1,0,At,B0); BAR; SCHED;
    STAGE(SB(0,1),Bt,bcol+HALF,t+2);
    WAIT_V(6); BAR; MMA(1,1,At,B1); BAR;
    LDB(B0,1,0); SCHED; LDA(At,1,0); STAGE(SA(0,1),A,brow+HALF,t+2);
    WAIT_L(8); BAR; WAIT_L(0); MMA(0,0,At,B0); BAR; SCHED;
    LDB(B1,1,1); STAGE(SB(1,0),Bt,bcol,t+3);
    BAR; WAIT_L(0); MMA(0,1,At,B1); BAR;
    LDA(At,1,1); STAGE(SA(1,0),A,brow,t+3);
    BAR; WAIT_L(0); MMA(1,0,At,B0); BAR; SCHED;
    STAGE(SB(1,1),Bt,bcol+HALF,t+3);
    WAIT_V(6); BAR; MMA(1,1,At,B1); BAR;
  }
  { LDB(B0,0,0); LDA(At,0,0); STAGE(SA(1,1),A,brow+HALF,nt-1);
    BAR; WAIT_L(0); MMA(0,0,At,B0); BAR;
    LDB(B1,0,1); BAR; WAIT_L(0); MMA(0,1,At,B1); BAR;
    LDA(At,0,1); WAIT_V(4); BAR; WAIT_L(0); MMA(1,0,At,B0); MMA(1,1,At,B1); BAR; }
  { LDB(B0,1,0); LDA(At,1,0); WAIT_V(2); BAR; WAIT_L(0); MMA(0,0,At,B0); BAR;
    LDB(B1,1,1); WAIT_V(0); BAR; WAIT_L(0); MMA(0,1,At,B1); BAR;
    LDA(At,1,1); BAR; WAIT_L(0); MMA(1,0,At,B0); MMA(1,1,At,B1); BAR; }
  if(wr==0)BAR;
  {
    float* eps = (float*)shm;
    const int er = tix >> 5, ec = (tix & 31) * 4;
    float* cbase = C + (long)((cpart ? 0 : brow) + er) * ldc + ((cpart ? 0 : bcol) + ec);
#pragma unroll
    for (int ai = 0; ai < 2; ++ai)
#pragma unroll
      for (int bj = 0; bj < 2; ++bj) {
        __syncthreads();
#pragma unroll
        for (int m = 0; m < 4; ++m)
#pragma unroll
          for (int n = 0; n < 2; ++n)
#pragma unroll
            for (int j = 0; j < 4; ++j) eps[(wr * 64 + m * 16 + fq * 4 + j) * 132 + wc * 32 + n * 16 + fr] = acc[ai][bj][m][n][j];
        __syncthreads();
        if (MODE == 0 && C16 != nullptr && pn >= 17) {
#pragma unroll
          for (int i = 0; i < 8; ++i) {
            const float4 v = *(const float4*)(eps + (er + 16 * i) * 132 + ec);
            uint2 o; o.x = cvtpk(v.x, v.y); o.y = cvtpk(v.z, v.w);
            *(uint2*)(C16 + (long)(brow + er + ai * HALF + 16 * i) * 2048 + ((pn - 17) * 256 + bj * HALF + ec)) = o;
          }
        } else {
#pragma unroll
          for (int i = 0; i < 8; ++i) {
            float4 v = *(const float4*)(eps + (er + 16 * i) * 132 + ec);
            float4* gp = (float4*)(cbase + (long)(ai * HALF + 16 * i) * ldc + bj * HALF);
            if (MODE == 1) { const float4 o = *gp; v.x += o.x; v.y += o.y; v.z += o.z; v.w += o.w; }
            *gp = v;
          }
        }
      }
    __syncthreads();
  }
}
#undef SA
#undef SB
#undef STAGE
#undef LDA
#undef LDB
#undef MMA
template <int MODE> __device__ __forceinline__ void phase_gemm(const bf16* A, const bf16* Bt, float* C, int M, int N, int wv, int ldc, unsigned short* C16) {
  const int nwg = (M / 256) * (N / 256);
  for (int t = blockIdx.x; t < nwg; t += gridDim.x) gemm_tile<MODE>(A, Bt, C, M, N, t, wv, -1, 0, 0, 32, ldc, 0, C16);
  __syncthreads();
}

__device__ __forceinline__ void phase_gemm_out(const bf16* A, const bf16* Bt, float* H, float* PB, int M, int N, int wv) {
#pragma unroll 1
  for (int t = blockIdx.x; t < 256; t += gridDim.x) gemm_tile<1>(A, Bt, H, M, N, t, wv, t >> 3, t & 7, 0, 32, N, 0);
#pragma unroll 1
  for (int i = blockIdx.x; i < 192; i += gridDim.x) {
    const int lt = i >> 3, ch = i & 7;
    gemm_tile<0>(A, Bt, PB + (size_t)i * 65536, M, N, 0, wv, 32 + (lt >> 3), lt & 7, ch * 4, 4, 256, 1);
  }
  __syncthreads();
}

__device__ __forceinline__ void phase_prep(CP& p, int l, int wv) {
  extern __shared__ __attribute__((aligned(16))) unsigned char smem_raw[];
  float* xs_t = (float*)smem_raw;
  unsigned short* xs16 = (unsigned short*)(smem_raw + 40960);
  float* gl = (float*)(smem_raw + 57600);
  const unsigned short* wtg = (const unsigned short*)(p.ws + WS_WTG);
  const int tid = opaque_tid(wv), lane = tid & 63, w = tid >> 6;
  const float* proj = (const float*)(p.ws + WS_PROJ);
  float* prep = (float*)(p.ws + WS_PREP);
  const float* conv_a = p.in[11] + (size_t)l * 4 * 1536;
  const float* cst_a = p.in[3] + (size_t)l * 128 * 3 * 1536;
  const float* conv_b = p.in[15] + (size_t)l * 4 * 512;
  const float* cbb = p.in[16] + (size_t)l * 512;
  const float* cst_b = p.in[5] + (size_t)l * 128 * 3 * 512;
  const float* wa = p.in[17] + (size_t)l * 4 * 128 * 128;
  const float* ba = p.in[18] + (size_t)l * 512;
  const float* wx = p.in[19] + (size_t)l * 4 * 128 * 128;
  const float* bx = p.in[20] + (size_t)l * 512;
  const float* lam = p.in[21] + (size_t)l * 512;
  const float* w2 = p.in[22] + (size_t)l * 16 * 256;
  const float* b2 = p.in[23] + (size_t)l * 256;
  const float* a_log = p.in[12] + l * 4;
  const float* dt_bias = p.in[13] + l * 4;

  for (int tt = blockIdx.x; tt < MROWS / 16; tt += gridDim.x) {
    const int r0 = tt * 16;
    const bool pr = r0 < NPR;
    const int t0 = pr ? (r0 % LP) : 0;
    const int s0 = r0 - NPR;
    if (tid < 64) {
      const int i = tid >> 2, hh = tid & 3;
      const float* pr_ = proj + (size_t)(r0 + i) * LDP;
      const float g = -expf(a_log[hh]) * softplusf_(pr_[C_ALPHA + hh] + dt_bias[hh]);
      prep[(size_t)(r0 + i) * PREP_LD + P_AB + hh] = expf(g);
      prep[(size_t)(r0 + i) * PREP_LD + P_AB + 4 + hh] = sigmoidf_(pr_[C_BETA + hh]);
    }
    {
      const int c = tid;
      const float w0 = conv_b[0 * 512 + c], w1 = conv_b[1 * 512 + c], w2_ = conv_b[2 * 512 + c], w3 = conv_b[3 * 512 + c];
      const float bias = cbb[c];
      if (pr) {
        float xw[19];
#pragma unroll
        for (int q = 0; q < 19; ++q) {
          const int t = t0 - 3 + q;
          xw[q] = 0.f;
          if (t >= 0) xw[q] = proj[(size_t)(r0 - 3 + q) * LDP + C_XB + c];
        }
#pragma unroll
        for (int i = 0; i < 16; ++i) { const float xv_ = bias + w3 * xw[i + 3] + w2_ * xw[i + 2] + w1 * xw[i + 1] + w0 * xw[i]; xs_t[c * 20 + i] = xv_; xs16[i * 520 + c] = f2bf(xv_); }
      } else {
#pragma unroll
        for (int bq = 0; bq < 4; ++bq) {
          const int bb = (s0 >> 2) + bq;
          float xw[7];
#pragma unroll
          for (int q = 0; q < 3; ++q) xw[q] = cst_b[((size_t)bb * 3 + q) * 512 + c];
#pragma unroll
          for (int q = 0; q < 4; ++q) xw[3 + q] = proj[(size_t)(r0 + bq * 4 + q) * LDP + C_XB + c];
#pragma unroll
          for (int q = 0; q < 4; ++q) { const float xv_ = bias + w3 * xw[q + 3] + w2_ * xw[q + 2] + w1 * xw[q + 1] + w0 * xw[q]; xs_t[c * 20 + bq * 4 + q] = xv_; xs16[(bq * 4 + q) * 520 + c] = f2bf(xv_); }
        }
      }
    }
    __syncthreads();
    {
      const int blk = w >> 1, g = w & 1;
      const unsigned short* wg = wtg + ((size_t)((l * 4 + blk) * 2 + g) * 128) * 128;
      const int mrow = lane & 15, q = lane >> 4;
      bf16x8 afr[4];
#pragma unroll
      for (int ks = 0; ks < 4; ++ks) afr[ks] = *(const bf16x8*)(xs16 + mrow * 520 + blk * 128 + ks * 32 + q * 8);
      f32x4 acc[8];
#pragma unroll
      for (int nt = 0; nt < 8; ++nt) {
        acc[nt] = (f32x4){0.f, 0.f, 0.f, 0.f};
#pragma unroll
        for (int ks = 0; ks < 4; ++ks) {
          const bf16x8 bfr = *(const bf16x8*)(wg + (size_t)(nt * 16 + mrow) * 128 + ks * 32 + q * 8);
          acc[nt] = __builtin_amdgcn_mfma_f32_16x16x32_bf16(afr[ks], bfr, acc[nt], 0, 0, 0);
        }
      }
#pragma unroll
      for (int nt = 0; nt < 8; ++nt)
#pragma unroll
        for (int jj = 0; jj < 4; ++jj) gl[(g * 16 + q * 4 + jj) * 512 + blk * 128 + nt * 16 + mrow] = acc[nt][jj];
    }
    __syncthreads();
    {
      const int ch = tid;
      const float bav = ba[ch], bxv = bx[ch];
      const float sp = softplusf_(-lam[ch]);
#pragma unroll
      for (int i = 0; i < 16; ++i) {
        const float xb = xs_t[ch * 20 + i];
        const float rg = sigmoidf_(gl[i * 512 + ch] + bav), ig = sigmoidf_(gl[(16 + i) * 512 + ch] + bxv);
        const float log_a = -8.f * rg * sp;
        const float a = __expf(log_a);
        const float x2 = 2.f * log_a;
        const float om = x2 > -0.02f ? -x2 * (1.f + x2 * (0.5f + x2 * (1.f / 6.f))) : 1.f - a * a;
        const float bc = __builtin_amdgcn_sqrtf(om) * (ig * xb);
        prep[(size_t)(r0 + i) * PREP_LD + P_LA + ch] = a;
        prep[(size_t)(r0 + i) * PREP_LD + P_LB + ch] = bc;
      }
    }
    __syncthreads();
  }
  {
    const int gw = blockIdx.x * 8 + wv, GW = gridDim.x * 8;
#pragma unroll 1
    for (int it = gw; it < (MROWS / 16) * 44; it += GW) {
      const int tt = it / 44, sub = it % 44;
      const int r0 = tt * 16;
      const bool pr = r0 < NPR;
      const int t0 = pr ? (r0 % LP) : 0;
      const int s0 = r0 - NPR;
    if (sub < 24) {
      const int vec = sub % 12, hf = sub / 12, ib = hf * 8;
      const int cc = vec * 128 + lane * 2;
      const float2 wv0 = *(const float2*)(conv_a + 0 * 1536 + cc), wv1 = *(const float2*)(conv_a + 1 * 1536 + cc);
      const float2 wv2 = *(const float2*)(conv_a + 2 * 1536 + cc), wv3 = *(const float2*)(conv_a + 3 * 1536 + cc);
#define CONV_OUT(i_, x0, x1, x2, x3) do { \
        float y0 = wv3.x * (x0).x + wv2.x * (x1).x + wv1.x * (x2).x + wv0.x * (x3).x; \
        float y1 = wv3.y * (x0).y + wv2.y * (x1).y + wv1.y * (x2).y + wv0.y * (x3).y; \
        y0 = siluf_(y0); y1 = siluf_(y1); \
        if (vec < 8) { const float ss = wave_allsum(y0 * y0 + y1 * y1); float sc = __builtin_amdgcn_rsqf(ss + 1e-6f); \
          if (vec < 4) sc *= 0.08838834764831845f; y0 *= sc; y1 *= sc; } \
        *(float2*)(prep + (size_t)(r0 + (i_)) * PREP_LD + cc) = make_float2(y0, y1); } while (0)
      if (pr) {
        float2 xw[11];
#pragma unroll
        for (int q = 0; q < 11; ++q) {
          const int t = t0 + ib - 3 + q;
          const float* ptr = proj + (size_t)(r0 + ib - 3 + q) * LDP + cc;
          xw[q] = (t >= 0) ? *(const float2*)ptr : make_float2(0.f, 0.f);
        }
#pragma unroll
        for (int ii = 0; ii < 8; ++ii) CONV_OUT(ib + ii, xw[ii + 3], xw[ii + 2], xw[ii + 1], xw[ii]);
      } else {
#pragma unroll 2
        for (int ii = 0; ii < 8; ++ii) {
          const int i = ib + ii;
          const int tl = (s0 + i) & 3, bb = (s0 + i) >> 2;
          const float* cs = cst_a + (size_t)bb * 3 * 1536 + cc;
          const float* pj = proj + (size_t)(r0 + i) * LDP + cc;
          const float2 x0 = *(const float2*)pj;
          const float2 x1 = tl >= 1 ? *(const float2*)(pj - LDP) : *(const float2*)(cs + (2 + tl) * 1536);
          const float2 x2 = tl >= 2 ? *(const float2*)(pj - 2 * LDP) : *(const float2*)(cs + (1 + tl) * 1536);
          const float2 x3 = tl >= 3 ? *(const float2*)(pj - 3 * LDP) : *(const float2*)(cs + (0 + tl) * 1536);
          CONV_OUT(i, x0, x1, x2, x3);
        }
      }
#undef CONV_OUT
    }
    else if (sub < 28) {
      const int cq = sub - 24, ch = cq * 64 + lane;
      float rcv[4];
#pragma unroll
      for (int m = 0; m < 4; ++m) rcv[m] = proj[(size_t)(r0 + (lane >> 4) + 4 * m) * LDP + C_RC + (lane & 15)];
      float w2v[16];
#pragma unroll
      for (int jj = 0; jj < 16; ++jj) w2v[jj] = w2[jj * 256 + ch];
      const float b2v = b2[ch];
      float qv[16], kv[16];
#pragma unroll
      for (int i = 0; i < 16; ++i) { qv[i] = proj[(size_t)(r0 + i) * LDP + C_QC + ch]; kv[i] = proj[(size_t)(r0 + i) * LDP + C_KC + ch]; }
      float P = 1.f;
#pragma unroll
      for (int i = 0; i < 16; ++i) {
        float z = b2v;
#pragma unroll
        for (int jj = 0; jj < 16; ++jj)
          z += __builtin_bit_cast(float, __builtin_amdgcn_readlane(__builtin_bit_cast(int, rcv[i >> 2]), (i & 3) * 16 + jj)) * w2v[jj];
        const float al = __expf(-softplusf_(-z) * (1.f / 16.f));
        float* pp = prep + (size_t)(r0 + i) * PREP_LD;
        if (pr) { P *= al; pp[P_QC + ch] = qv[i] * 0.125f * P; pp[P_KC + ch] = kv[i] * __builtin_amdgcn_rcpf(P); }
        else { pp[P_QC + ch] = qv[i] * 0.125f; pp[P_KC + ch] = kv[i]; pp[P_AC + ch] = al; }
      }
      if (pr) ((float*)(p.ws + WS_GDEC))[(size_t)tt * 256 + ch] = P;
    } else {
      const int i = sub - 28;
      const int pos = pr ? (t0 + i) : (16384 + ((s0 + i) & 3));
      const float* pr_ = proj + (size_t)(r0 + i) * LDP;
      float* pp = prep + (size_t)(r0 + i) * PREP_LD;
      const int f = lane & 31, hb = lane >> 5;
      const float freq = __builtin_amdgcn_exp2f(-(float)f * (13.287712379549449f / 32.f));
      const float ang = (float)pos * freq;
      double rev = (double)ang * 0.15915494309189535;
      rev -= floor(rev);
      const float fr_ = (float)rev;
      const float cs = __builtin_amdgcn_cosf(fr_), sn = __builtin_amdgcn_sinf(fr_);
#pragma unroll
      for (int m = 0; m < 2; ++m) {
        const int hh = hb + 2 * m;
        float gq = 1.f, gk = 0.125f;
        if (pr) { const float lgam = __builtin_amdgcn_logf(1.f - __builtin_amdgcn_exp2f(-5.f - (float)hh)); gq = __builtin_amdgcn_exp2f((float)(i + 1) * lgam); gk = 0.125f * __builtin_amdgcn_exp2f(-(float)(i + 1) * lgam); }
        const float q1 = pr_[C_QD + hh * 64 + f] * gq, q2 = pr_[C_QD + hh * 64 + 32 + f] * gq;
        const float k1 = pr_[C_KD + hh * 64 + f] * gk, k2 = pr_[C_KD + hh * 64 + 32 + f] * gk;
        pp[P_QD + hh * 64 + f] = q1 * cs - q2 * sn;
        pp[P_QD + hh * 64 + 32 + f] = q2 * cs + q1 * sn;
        pp[P_KD + hh * 64 + f] = k1 * cs - k2 * sn;
        pp[P_KD + hh * 64 + 32 + f] = k2 * cs + k1 * sn;
      }
    }
    }
  }
  const size_t gtid = (size_t)blockIdx.x * NTHR + tid, gsz = (size_t)gridDim.x * NTHR;
  for (size_t idx = gtid; idx < (size_t)132 * 3 * 2048; idx += gsz) {
    const int c = (int)(idx & 2047), jj = (int)((idx >> 11) % 3), bb = (int)(idx / (2048 * 3));
    const size_t row = bb < 4 ? (size_t)(bb * LP + LP - 3 + jj) : (size_t)(NPR + (bb - 4) * 4 + 1 + jj);
    if (c < 1536) {
      const float v = proj[row * LDP + c];
      if (bb < 4) p.out[O_PDC + ((size_t)(l * 4 + bb) * 3 + jj) * 1536 + c] = v;
      else p.out[O_SDC + ((size_t)(l * 128 + bb - 4) * 3 + jj) * 1536 + c] = v;
    } else {
      const int c2 = c - 1536;
      const float v = proj[row * LDP + C_XB + c2];
      if (bb < 4) p.out[O_PLC + ((size_t)(l * 4 + bb) * 3 + jj) * 512 + c2] = v;
      else p.out[O_SLC + ((size_t)(l * 128 + bb - 4) * 3 + jj) * 512 + c2] = v;
    }
  }
}

using f2 = __attribute__((ext_vector_type(2))) float;
constexpr int NST = LP / 16;

template <int MODE>
__device__ __forceinline__ void scan_prompt_half(CP& p, int l, int bh, int cg, float* sm, int rt) {
  constexpr int DK = MODE == 0 ? 128 : 64;
  constexpr int EPL = DK / 16, E2 = EPL / 2;
  constexpr int QOFF = MODE == 0 ? P_QA : (MODE == 1 ? P_QC : P_QD);
  constexpr int KOFF = MODE == 0 ? P_KA : (MODE == 1 ? P_KC : P_KD);
  constexpr int OB = MODE == 0 ? 0 : (MODE == 1 ? 1024 : 1536);
  constexpr int BUFSZ = 48 * DK + 256 + 32;
  const int lane = rt & 63, wl = rt >> 6;
  const int b = bh >> 2, h = bh & 3;
  const int j = lane & 15, cl = wl * 4 + (lane >> 4);
  const float* prep = (const float*)(p.ws + WS_PREP) + (size_t)(b * LP) * PREP_LD;
  const float* proj = (const float*)(p.ws + WS_PROJ) + (size_t)(b * LP) * LDP;
  float* obuf = (float*)(p.ws + WS_OBUF) + (size_t)(b * LP) * 2048;
  f2 s[E2];
#pragma unroll
  for (int e = 0; e < E2; ++e) s[e] = (f2){0.f, 0.f};
  const float gamma = 1.f - exp2f(-5.f - (float)h);
  const int lt0 = rt / (DK / 4), lc0 = (rt % (DK / 4)) * 4;
  const int lt1 = (rt + 256) / (DK / 4);
  const bool ld_v = rt < 64;
  const int vt = rt >> 2, vc = (rt & 3) * 4;
  float4 rq0_0 = make_float4(0, 0, 0, 0), rq1_0 = rq0_0, rk0_0 = rq0_0, rk1_0 = rq0_0, ral_0 = rq0_0, rv_0 = rq0_0; float rsc_0 = 0.f;
  float4 rq0_1 = rq0_0, rq1_1 = rq0_0, rk0_1 = rq0_0, rk1_1 = rq0_0, ral_1 = rq0_0, rv_1 = rq0_0; float rsc_1 = 0.f;
#define GLOAD(st_, S) do { const int t0_ = (st_) * 16; \
    { const float* rp_ = prep + (size_t)(t0_ + lt0) * PREP_LD; rq0_##S = *(const float4*)(rp_ + QOFF + h * DK + lc0); \
      rk0_##S = *(const float4*)(rp_ + KOFF + h * DK + lc0); if (MODE == 1) ral_##S = *(const float4*)(rp_ + P_AC + h * 64 + lc0); } \
    if (MODE == 0) { const float* rp_ = prep + (size_t)(t0_ + lt1) * PREP_LD; rq1_##S = *(const float4*)(rp_ + QOFF + h * DK + lc0); \
      rk1_##S = *(const float4*)(rp_ + KOFF + h * DK + lc0); } \
    if (ld_v) { if (MODE == 0) rv_##S = *(const float4*)(prep + (size_t)(t0_ + vt) * PREP_LD + P_VA + h * 128 + cg * 16 + vc); \
      else rv_##S = *(const float4*)(proj + (size_t)(t0_ + vt) * LDP + (MODE == 1 ? C_VC : C_VD) + h * 128 + cg * 16 + vc); } \
    if (MODE == 0 && rt < 32) rsc_##S = prep[(size_t)(t0_ + (rt & 15)) * PREP_LD + (rt < 16 ? P_AB : P_AB + 4) + h]; } while (0)
#define LSTORE(bf_, S) do { *(float4*)((bf_) + lt0 * DK + lc0) = rq0_##S; *(float4*)((bf_) + 16 * DK + lt0 * DK + lc0) = rk0_##S; \
    if (MODE == 1) *(float4*)((bf_) + 32 * DK + lt0 * DK + lc0) = ral_##S; \
    if (MODE == 0) { *(float4*)((bf_) + lt1 * DK + lc0) = rq1_##S; *(float4*)((bf_) + 16 * DK + lt1 * DK + lc0) = rk1_##S; } \
    if (ld_v) *(float4*)((bf_) + 48 * DK + vt * 16 + vc) = rv_##S; \
    if (MODE == 0 && rt < 32) (bf_)[48 * DK + 256 + rt] = rsc_##S; } while (0)
  GLOAD(0, 0);
  LSTORE(sm, 0);
  GLOAD(1, 1);
  __syncthreads();
  auto stage = [&](const int st, const int SL) __attribute__((always_inline)) {
    const float* bf = sm + (st & 1) * BUFSZ;
    float* bn = sm + ((st + 1) & 1) * BUFSZ;
    if (st + 2 < NST) { if (SL == 0) GLOAD(st + 2, 0); else GLOAD(st + 2, 1); }
    float okeep = 0.f;
    f2 kkb[3][E2], qqb[3][E2]; float vvb[3], aab[3], beb[3]; float4 alb[3];
#define LOADTOK(ti_, S_) do { \
      _Pragma("unroll") for (int e4 = 0; e4 < EPL / 4; ++e4) { \
        const float4 k4 = *(const float4*)(bf + 16 * DK + (ti_) * DK + j * EPL + e4 * 4); \
        const float4 q4 = *(const float4*)(bf + (ti_) * DK + j * EPL + e4 * 4); \
        kkb[S_][e4 * 2 + 0] = (f2){k4.x, k4.y}; kkb[S_][e4 * 2 + 1] = (f2){k4.z, k4.w}; \
        qqb[S_][e4 * 2 + 0] = (f2){q4.x, q4.y}; qqb[S_][e4 * 2 + 1] = (f2){q4.z, q4.w}; } \
      vvb[S_] = bf[48 * DK + (ti_) * 16 + cl]; \
      if (MODE == 0) { aab[S_] = bf[48 * DK + 256 + (ti_)]; beb[S_] = bf[48 * DK + 256 + 16 + (ti_)]; } \
      if (MODE == 1) alb[S_] = *(const float4*)(bf + 32 * DK + (ti_) * DK + j * EPL); } while (0)
    LOADTOK(0, 0);
    LOADTOK(1, 1);
#pragma unroll
    for (int ti = 0; ti < 16; ++ti) {
      constexpr int dummy_ = 0; (void)dummy_;
      const int cs = ti % 3;
      if (ti + 2 < 16) { LOADTOK(ti + 2, (ti + 2) % 3); }
      __builtin_amdgcn_sched_barrier(0);
      f2 kk[E2], qq[E2];
#pragma unroll
      for (int e = 0; e < E2; ++e) { kk[e] = kkb[cs][e]; qq[e] = qqb[cs][e]; }
      const float vv = vvb[cs];
      if (MODE == 0) {
        f2 ra = kk[0] * s[0];
#pragma unroll
        for (int e = 1; e < E2; ++e) ra = kk[e] * s[e] + ra;
        const float r = row16_allsum(ra.x + ra.y);
        const float a = aab[cs], be = beb[cs];
        const float dd = be * (vv - a * r);
        const f2 a2 = (f2){a, a}, d2 = (f2){dd, dd};
#pragma unroll
        for (int e = 0; e < E2; ++e) s[e] = kk[e] * d2 + a2 * s[e];
      } else if (MODE == 1) {
        const float4 a4 = alb[cs];
        const f2 v2 = (f2){vv, vv};
        s[0] = kk[0] * v2 + ((f2){a4.x, a4.y}) * s[0];
        s[1] = kk[1] * v2 + ((f2){a4.z, a4.w}) * s[1];
      } else {
        const f2 v2 = (f2){vv, vv}, g2 = (f2){gamma, gamma};
#pragma unroll
        for (int e = 0; e < E2; ++e) s[e] = kk[e] * v2 + g2 * s[e];
      }
      f2 oa = qq[0] * s[0];
#pragma unroll
      for (int e = 1; e < E2; ++e) oa = qq[e] * s[e] + oa;
      const float o = row16_allsum(oa.x + oa.y);
      if (j == ti) okeep = o;
    }
#undef LOADTOK
    if (st + 1 < NST) { if (SL == 0) LSTORE(bn, 1); else LSTORE(bn, 0); }
    obuf[(size_t)(st * 16 + j) * 2048 + OB + h * 128 + cg * 16 + cl] = okeep;
    __syncthreads();
    };
#pragma unroll 1
  for (int st = 0; st + 1 < NST; st += 2) { stage(st, 0); stage(st + 1, 1); }
  stage(NST - 1, 0);
#undef GLOAD
#undef LSTORE
  float* so = p.out + (MODE == 0 ? O_PD : (MODE == 1 ? O_PG : O_PR)) + ((size_t)(l * 4 + b) * 4 + h) * DK * 128;
#pragma unroll
  for (int e = 0; e < E2; ++e) {
    so[(size_t)(j * EPL + 2 * e) * 128 + cg * 16 + cl] = s[e].x;
    so[(size_t)(j * EPL + 2 * e + 1) * 128 + cg * 16 + cl] = s[e].y;
  }
}

__device__ __forceinline__ void phase_prep2(CP& p, int wv) {
  extern __shared__ __attribute__((aligned(16))) unsigned char smem_raw[];
  const int tid = opaque_tid(wv), hd = tid >> 7, d = tid & 127;
  float* hs = (float*)smem_raw + hd * 4864;
  float* kS = hs; float* vS = hs + 2112; float* AS = hs + 4224; float* TS = hs + 4496; float* lgS = hs + 4768; float* gcS = hs + 4784; float* beS = hs + 4800;
  float* prep = (float*)(p.ws + WS_PREP);
#pragma unroll 1
  for (int tile = blockIdx.x; tile < 4 * NST; tile += gridDim.x) {
    const int r0 = tile * 16;
#pragma unroll
    for (int i = 0; i < 16; ++i) {
      kS[i * 132 + d] = prep[(size_t)(r0 + i) * PREP_LD + P_KA + hd * 128 + d];
      vS[i * 132 + d] = prep[(size_t)(r0 + i) * PREP_LD + P_VA + hd * 128 + d];
    }
    if (d < 16) { lgS[d] = logf(prep[(size_t)(r0 + d) * PREP_LD + P_AB + hd]); beS[d] = prep[(size_t)(r0 + d) * PREP_LD + P_AB + 4 + hd]; }
    __syncthreads();
    if (d < 16) { float g = 0.f; for (int m = 0; m <= d; ++m) g += lgS[m]; gcS[d] = g; }
    float dots[2];
#pragma unroll
    for (int e2 = 0; e2 < 2; ++e2) {
      const int e = d + 128 * e2, i = e >> 4, m = e & 15;
      float acc = 0.f;
      if (m < i) {
        const float4* ki = (const float4*)(kS + i * 132); const float4* km = (const float4*)(kS + m * 132);
#pragma unroll 8
        for (int c = 0; c < 32; ++c) { const float4 x = ki[c], y = km[c]; acc += x.x * y.x + x.y * y.y + x.z * y.z + x.w * y.w; }
      }
      dots[e2] = acc;
    }
    __syncthreads();
#pragma unroll
    for (int e2 = 0; e2 < 2; ++e2) {
      const int e = d + 128 * e2, i = e >> 4, m = e & 15;
      AS[i * 17 + m] = (m < i) ? beS[i] * dots[e2] * __expf(gcS[i] - gcS[m]) : 0.f;
    }
    __syncthreads();
    if (d < 16) {
      float tcol[16];
#pragma unroll
      for (int i = 0; i < 16; ++i) {
        float t = (i == d) ? 1.f : 0.f;
#pragma unroll
        for (int m = 0; m < i; ++m) t -= AS[i * 17 + m] * tcol[m];
        tcol[i] = t;
      }
#pragma unroll
      for (int i = 0; i < 16; ++i) TS[i * 17 + d] = tcol[i];
    }
    __syncthreads();
    {
      float xk[16], xv[16];
#pragma unroll
      for (int m = 0; m < 16; ++m) { const float bm = beS[m]; xk[m] = bm * __expf(gcS[m]) * kS[m * 132 + d]; xv[m] = bm * vS[m * 132 + d]; }
      const float g15 = gcS[15];
#pragma unroll
      for (int i = 0; i < 16; ++i) {
        float W = 0.f, U = 0.f;
#pragma unroll
        for (int m = 0; m <= i; ++m) { const float t = TS[i * 17 + m]; W += t * xk[m]; U += t * xv[m]; }
        float* pp = prep + (size_t)(r0 + i) * PREP_LD;
        pp[P_WA + hd * 128 + d] = W;
        pp[P_VA + hd * 128 + d] = U;
        pp[P_KH + hd * 128 + d] = kS[i * 132 + d] * __expf(g15 - gcS[i]);
      }
      if (d < 16) prep[(size_t)(r0 + d) * PREP_LD + P_GC + hd] = __expf(gcS[d]);
#pragma unroll
      for (int e2 = 0; e2 < 2; ++e2) {
        const int e = d + 128 * e2, i = e >> 4, m = e & 15;
        prep[(size_t)(r0 + i) * PREP_LD + P_DM + hd * 16 + m] = (m <= i) ? __expf(gcS[i] - gcS[m]) : 0.f;
      }
    }
    __syncthreads();
  }
}

__device__ __forceinline__ void scan_prompt_delta_mfma(CP& p, int l, int bh, int half, float* sm, int rt) {
  constexpr int BUFSZ = 10464;
  const int lane = rt & 63, wl = rt >> 6, n = lane & 15, q = lane >> 4;
  const int b = bh >> 2, h = bh & 3;
  const int col0 = half * 64 + wl * 16;
  const float* prep = (const float*)(p.ws + WS_PREP) + (size_t)(b * LP) * PREP_LD;
  float* obuf = (float*)(p.ws + WS_OBUF) + (size_t)(b * LP) * 2048 + h * 128 + col0 + n;
  f32x4 St[8];
#pragma unroll
  for (int kt = 0; kt < 8; ++kt) St[kt] = (f32x4){0.f, 0.f, 0.f, 0.f};
  const int lt0 = rt >> 5, lt1 = lt0 + 8, lc = (rt & 31) * 4;
  const int tt_ = rt & 15, tc = (rt >> 4) * 4;
  float4 rq0_0, rq1_0, rk0_0, rk1_0, rw0_0, rw1_0, rh0_0, rh1_0, ru_0, rd_0 = make_float4(0, 0, 0, 0); float rg_0 = 0.f;
  float4 rq0_1, rq1_1, rk0_1, rk1_1, rw0_1, rw1_1, rh0_1, rh1_1, ru_1, rd_1 = make_float4(0, 0, 0, 0); float rg_1 = 0.f;
  rq0_0 = rq1_0 = rk0_0 = rk1_0 = rw0_0 = rw1_0 = rh0_0 = rh1_0 = ru_0 = make_float4(0, 0, 0, 0);
  rq0_1 = rq1_1 = rk0_1 = rk1_1 = rw0_1 = rw1_1 = rh0_1 = rh1_1 = ru_1 = make_float4(0, 0, 0, 0);
#define GLOADD(st_, S) do { const float* ra_ = prep + (size_t)((st_) * 16 + lt0) * PREP_LD + h * 128 + lc; \
    const float* rb_ = prep + (size_t)((st_) * 16 + lt1) * PREP_LD + h * 128 + lc; \
    rq0_##S = *(const float4*)(ra_ + P_QA); rq1_##S = *(const float4*)(rb_ + P_QA); rk0_##S = *(const float4*)(ra_ + P_KA); rk1_##S = *(const float4*)(rb_ + P_KA); \
    rw0_##S = *(const float4*)(ra_ + P_WA); rw1_##S = *(const float4*)(rb_ + P_WA); \
    const float* rt__ = prep + (size_t)((st_) * 16 + tt_) * PREP_LD + h * 128; \
    rh0_##S = *(const float4*)(rt__ + P_KH + tc); rh1_##S = *(const float4*)(rt__ + P_KH + 64 + tc); \
    ru_##S = *(const float4*)(rt__ + P_VA + half * 64 + tc); \
    if (rt < 16) rg_##S = prep[(size_t)((st_) * 16 + rt) * PREP_LD + P_GC + h]; \
    if (rt < 64) rd_##S = *(const float4*)(prep + (size_t)((st_) * 16 + (rt >> 2)) * PREP_LD + P_DM + h * 16 + (rt & 3) * 4); } while (0)
#define LSTORED(bf_, S) do { *(float4*)((bf_) + lt0 * 132 + lc) = rq0_##S; *(float4*)((bf_) + lt1 * 132 + lc) = rq1_##S; \
    *(float4*)((bf_) + 2112 + lt0 * 132 + lc) = rk0_##S; *(float4*)((bf_) + 2112 + lt1 * 132 + lc) = rk1_##S; \
    *(float4*)((bf_) + 4224 + lt0 * 132 + lc) = rw0_##S; *(float4*)((bf_) + 4224 + lt1 * 132 + lc) = rw1_##S; \
    (bf_)[6336 + (tc + 0) * 20 + tt_] = rh0_##S.x; (bf_)[6336 + (tc + 1) * 20 + tt_] = rh0_##S.y; (bf_)[6336 + (tc + 2) * 20 + tt_] = rh0_##S.z; (bf_)[6336 + (tc + 3) * 20 + tt_] = rh0_##S.w; \
    (bf_)[6336 + (tc + 64) * 20 + tt_] = rh1_##S.x; (bf_)[6336 + (tc + 65) * 20 + tt_] = rh1_##S.y; (bf_)[6336 + (tc + 66) * 20 + tt_] = rh1_##S.z; (bf_)[6336 + (tc + 67) * 20 + tt_] = rh1_##S.w; \
    (bf_)[8896 + (tc + 0) * 20 + tt_] = ru_##S.x; (bf_)[8896 + (tc + 1) * 20 + tt_] = ru_##S.y; (bf_)[8896 + (tc + 2) * 20 + tt_] = ru_##S.z; (bf_)[8896 + (tc + 3) * 20 + tt_] = ru_##S.w; \
    if (rt < 16) (bf_)[10176 + rt] = rg_##S; \
    if (rt < 64) *(float4*)((bf_) + 10208 + rt * 4) = rd_##S; } while (0)
  GLOADD(0, 0);
  LSTORED(sm, 0);
  GLOADD(1, 1);
  __syncthreads();
  auto stage = [&](const int st, const int SL) __attribute__((always_inline)) {
    const float* bf = sm + (st & 1) * BUFSZ;
    float* bn = sm + ((st + 1) & 1) * BUFSZ;
    if (st + 2 < NST) { if (SL == 0) GLOADD(st + 2, 0); else GLOADD(st + 2, 1); }
    const float4 egm = *(const float4*)(bf + 10176 + 4 * q);
    const float4 dm4 = *(const float4*)(bf + 10208 + n * 16 + 4 * q);
    const float e15 = bf[10176 + 15];
    f32x4 ws = (f32x4){0.f, 0.f, 0.f, 0.f}, qs = ws, pt = ws;
#pragma unroll
    for (int ks = 0; ks < 4; ++ks) {
      const int o0 = n * 132 + 32 * ks + 4 * q;
      const float4 qa = *(const float4*)(bf + o0), qb = *(const float4*)(bf + o0 + 16);
      const float4 ka = *(const float4*)(bf + 2112 + o0), kb = *(const float4*)(bf + 2112 + o0 + 16);
      const float4 wa = *(const float4*)(bf + 4224 + o0), wb = *(const float4*)(bf + 4224 + o0 + 16);
      const bf16x8 QF = mkfrag(cvtpk(qa.x, qa.y), cvtpk(qa.z, qa.w), cvtpk(qb.x, qb.y), cvtpk(qb.z, qb.w));
      const bf16x8 KF = mkfrag(cvtpk(ka.x, ka.y), cvtpk(ka.z, ka.w), cvtpk(kb.x, kb.y), cvtpk(kb.z, kb.w));
      const bf16x8 WF = mkfrag(cvtpk(wa.x, wa.y), cvtpk(wa.z, wa.w), cvtpk(wb.x, wb.y), cvtpk(wb.z, wb.w));
      const bf16x8 SB = mkfrag(cvtpk(St[2 * ks][0], St[2 * ks][1]), cvtpk(St[2 * ks][2], St[2 * ks][3]),
                               cvtpk(St[2 * ks + 1][0], St[2 * ks + 1][1]), cvtpk(St[2 * ks + 1][2], St[2 * ks + 1][3]));
      ws = __builtin_amdgcn_mfma_f32_16x16x32_bf16(WF, SB, ws, 0, 0, 0);
      qs = __builtin_amdgcn_mfma_f32_16x16x32_bf16(QF, SB, qs, 0, 0, 0);
      pt = __builtin_amdgcn_mfma_f32_16x16x32_bf16(KF, QF, pt, 0, 0, 0);
    }
    const float4 u4 = *(const float4*)(bf + 8896 + (wl * 16 + n) * 20 + 4 * q);
    const float vn0 = u4.x - ws[0], vn1 = u4.y - ws[1], vn2 = u4.z - ws[2], vn3 = u4.w - ws[3];
    const bf16x8 VNF = mkfrag(cvtpk(vn0, vn1), cvtpk(vn2, vn3), 0u, 0u);
    const float p0 = pt[0] * dm4.x, p1 = pt[1] * dm4.y, p2 = pt[2] * dm4.z, p3 = pt[3] * dm4.w;
    const bf16x8 PF = mkfrag(cvtpk(p0, p1), cvtpk(p2, p3), 0u, 0u);
    f32x4 qsc;
    qsc[0] = qs[0] * egm.x; qsc[1] = qs[1] * egm.y; qsc[2] = qs[2] * egm.z; qsc[3] = qs[3] * egm.w;
    const f32x4 o = __builtin_amdgcn_mfma_f32_16x16x32_bf16(PF, VNF, qsc, 0, 0, 0);
#pragma unroll
    for (int r = 0; r < 4; ++r) obuf[(size_t)(st * 16 + 4 * q + r) * 2048] = o[r];
#pragma unroll
    for (int kt = 0; kt < 8; ++kt) {
      const float4 k4 = *(const float4*)(bf + 6336 + (16 * kt + n) * 20 + 4 * q);
      const bf16x8 KTF = mkfrag(cvtpk(k4.x, k4.y), cvtpk(k4.z, k4.w), 0u, 0u);
      f32x4 sc;
      sc[0] = St[kt][0] * e15; sc[1] = St[kt][1] * e15; sc[2] = St[kt][2] * e15; sc[3] = St[kt][3] * e15;
      St[kt] = __builtin_amdgcn_mfma_f32_16x16x32_bf16(KTF, VNF, sc, 0, 0, 0);
    }
    if (st + 1 < NST) { if (SL == 0) LSTORED(bn, 1); else LSTORED(bn, 0); }
    __syncthreads();
    };
#pragma unroll 1
  for (int st = 0; st + 1 < NST; st += 2) { stage(st, 0); stage(st + 1, 1); }
  stage(NST - 1, 0);
#undef GLOADD
#undef LSTORED
  float* so = p.out + O_PD + ((size_t)(l * 4 + b) * 4 + h) * 128 * 128 + col0 + n;
#pragma unroll
  for (int kt = 0; kt < 8; ++kt)
#pragma unroll
    for (int r = 0; r < 4; ++r) so[(size_t)(16 * kt + 4 * q + r) * 128] = St[kt][r];
}

template <int MODE>
__device__ __forceinline__ void scan_prompt_mfma(CP& p, int l, int bh, int half, float* sm, int rt) {
  constexpr int QOFF = MODE == 1 ? P_QC : P_QD, KOFF = MODE == 1 ? P_KC : P_KD, OB = MODE == 1 ? 1024 : 1536;
  constexpr int BUFSZ = 4800;
  const int lane = rt & 63, wl = rt >> 6, n = lane & 15, q = lane >> 4;
  const int b = bh >> 2, h = bh & 3;
  const int col0 = half * 64 + wl * 16;
  const float* prep = (const float*)(p.ws + WS_PREP) + (size_t)(b * LP) * PREP_LD + h * 64;
  const float* proj = (const float*)(p.ws + WS_PROJ) + (size_t)(b * LP) * LDP + (MODE == 1 ? C_VC : C_VD) + h * 128 + half * 64;
  float* obuf = (float*)(p.ws + WS_OBUF) + (size_t)(b * LP) * 2048 + OB + h * 128 + col0 + n;
  const float* gdec = (const float*)(p.ws + WS_GDEC) + (size_t)(b * NST) * 256 + h * 64;
  f32x4 St[4];
#pragma unroll
  for (int kt = 0; kt < 4; ++kt) St[kt] = (f32x4){0.f, 0.f, 0.f, 0.f};
  float g16 = 1.f - exp2f(-5.f - (float)h);
  g16 *= g16; g16 *= g16; g16 *= g16; g16 *= g16;
  const int lt = rt >> 4, lc = (rt & 15) * 4;
  const int tt_ = rt & 15, tc = (rt >> 4) * 4;
  float4 rq_0 = make_float4(0, 0, 0, 0), rk_0 = rq_0, rv_0 = rq_0, rp_0 = rq_0, rx_0 = rq_0, rq_1 = rq_0, rk_1 = rq_0, rv_1 = rq_0, rp_1 = rq_0, rx_1 = rq_0;
#define GLOADM(st_, S) do { const float* rp__ = prep + (size_t)((st_) * 16 + lt) * PREP_LD; \
    rq_##S = *(const float4*)(rp__ + QOFF + lc); rk_##S = *(const float4*)(rp__ + KOFF + lc); \
    rx_##S = *(const float4*)(prep + (size_t)((st_) * 16 + tt_) * PREP_LD + KOFF + tc); \
    rv_##S = *(const float4*)(proj + (size_t)((st_) * 16 + tt_) * LDP + tc); \
    if (MODE == 1 && rt < 16) rp_##S = *(const float4*)(gdec + (size_t)(st_) * 256 + rt * 4); } while (0)
#define LSTOREM(bf_, S) do { *(float4*)((bf_) + lt * 68 + lc) = rq_##S; *(float4*)((bf_) + 1088 + lt * 68 + lc) = rk_##S; \
    (bf_)[2176 + (tc + 0) * 20 + tt_] = rx_##S.x; (bf_)[2176 + (tc + 1) * 20 + tt_] = rx_##S.y; \
    (bf_)[2176 + (tc + 2) * 20 + tt_] = rx_##S.z; (bf_)[2176 + (tc + 3) * 20 + tt_] = rx_##S.w; \
    (bf_)[3456 + (tc + 0) * 20 + tt_] = rv_##S.x; (bf_)[3456 + (tc + 1) * 20 + tt_] = rv_##S.y; \
    (bf_)[3456 + (tc + 2) * 20 + tt_] = rv_##S.z; (bf_)[3456 + (tc + 3) * 20 + tt_] = rv_##S.w; \
    if (MODE == 1 && rt < 16) *(float4*)((bf_) + 4736 + rt * 4) = rp_##S; } while (0)
  GLOADM(0, 0);
  LSTOREM(sm, 0);
  GLOADM(1, 1);
  __syncthreads();
  auto stage = [&](const int st, const int SL) __attribute__((always_inline)) {
    const float* bf = sm + (st & 1) * BUFSZ;
    float* bn = sm + ((st + 1) & 1) * BUFSZ;
    if (st + 2 < NST) { if (SL == 0) GLOADM(st + 2, 0); else GLOADM(st + 2, 1); }
    bf16x8 QF[2], KF[2], SB[2];
#pragma unroll
    for (int ks = 0; ks < 2; ++ks) {
      const float4 qa = *(const float4*)(bf + n * 68 + 32 * ks + 4 * q), qb = *(const float4*)(bf + n * 68 + 32 * ks + 16 + 4 * q);
      const float4 ka = *(const float4*)(bf + 1088 + n * 68 + 32 * ks + 4 * q), kb = *(const float4*)(bf + 1088 + n * 68 + 32 * ks + 16 + 4 * q);
      QF[ks] = mkfrag(cvtpk(qa.x, qa.y), cvtpk(qa.z, qa.w), cvtpk(qb.x, qb.y), cvtpk(qb.z, qb.w));
      KF[ks] = mkfrag(cvtpk(ka.x, ka.y), cvtpk(ka.z, ka.w), cvtpk(kb.x, kb.y), cvtpk(kb.z, kb.w));
      SB[ks] = mkfrag(cvtpk(St[2 * ks][0], St[2 * ks][1]), cvtpk(St[2 * ks][2], St[2 * ks][3]),
                      cvtpk(St[2 * ks + 1][0], St[2 * ks + 1][1]), cvtpk(St[2 * ks + 1][2], St[2 * ks + 1][3]));
    }
    f32x4 qs = (f32x4){0.f, 0.f, 0.f, 0.f}, pt = qs;
    qs = __builtin_amdgcn_mfma_f32_16x16x32_bf16(QF[0], SB[0], qs, 0, 0, 0);
    qs = __builtin_amdgcn_mfma_f32_16x16x32_bf16(QF[1], SB[1], qs, 0, 0, 0);
    pt = __builtin_amdgcn_mfma_f32_16x16x32_bf16(KF[0], QF[0], pt, 0, 0, 0);
    pt = __builtin_amdgcn_mfma_f32_16x16x32_bf16(KF[1], QF[1], pt, 0, 0, 0);
#pragma unroll
    for (int r = 0; r < 4; ++r) if (4 * q + r > n) pt[r] = 0.f;
    const bf16x8 PF = mkfrag(cvtpk(pt[0], pt[1]), cvtpk(pt[2], pt[3]), 0u, 0u);
    const float4 v4 = *(const float4*)(bf + 3456 + (wl * 16 + n) * 20 + 4 * q);
    const bf16x8 VF = mkfrag(cvtpk(v4.x, v4.y), cvtpk(v4.z, v4.w), 0u, 0u);
    const f32x4 o = __builtin_amdgcn_mfma_f32_16x16x32_bf16(PF, VF, qs, 0, 0, 0);
#pragma unroll
    for (int r = 0; r < 4; ++r) obuf[(size_t)(st * 16 + 4 * q + r) * 2048] = o[r];
#pragma unroll
    for (int kt = 0; kt < 4; ++kt) {
      const float4 k4 = *(const float4*)(bf + 2176 + (16 * kt + n) * 20 + 4 * q);
      const bf16x8 KTF = mkfrag(cvtpk(k4.x, k4.y), cvtpk(k4.z, k4.w), 0u, 0u);
      St[kt] = __builtin_amdgcn_mfma_f32_16x16x32_bf16(KTF, VF, St[kt], 0, 0, 0);
      if (MODE == 1) {
        const float4 p4 = *(const float4*)(bf + 4736 + 16 * kt + 4 * q);
        St[kt][0] *= p4.x; St[kt][1] *= p4.y; St[kt][2] *= p4.z; St[kt][3] *= p4.w;
      } else {
        St[kt][0] *= g16; St[kt][1] *= g16; St[kt][2] *= g16; St[kt][3] *= g16;
      }
    }
    if (st + 1 < NST) { if (SL == 0) LSTOREM(bn, 1); else LSTOREM(bn, 0); }
    __syncthreads();
  };
#pragma unroll 1
  for (int st = 0; st + 1 < NST; st += 2) { stage(st, 0); stage(st + 1, 1); }
  stage(NST - 1, 0);
#undef GLOADM
#undef LSTOREM
  float* so = p.out + (MODE == 1 ? O_PG : O_PR) + ((size_t)(l * 4 + b) * 4 + h) * 64 * 128 + col0 + n;
#pragma unroll
  for (int kt = 0; kt < 4; ++kt)
#pragma unroll
    for (int r = 0; r < 4; ++r) so[(size_t)(16 * kt + 4 * q + r) * 128] = St[kt][r];
}

template <int MODE>
__device__ __forceinline__ void scan_sample(CP& p, int l, int item, int wv) {
  extern __shared__ __attribute__((aligned(16))) unsigned char smem_raw[];
  constexpr int DK = MODE == 0 ? 128 : 64;
  constexpr int NP = MODE == 0 ? 2 : 1;
  constexpr int RK = DK / NP;
  constexpr int E2 = RK / 2;
  constexpr int TPH = 128 * NP;
  constexpr int QOFF = MODE == 0 ? P_QA : (MODE == 1 ? P_QC : P_QD);
  constexpr int KOFF = MODE == 0 ? P_KA : (MODE == 1 ? P_KC : P_KD);
  constexpr int OB = MODE == 0 ? 0 : (MODE == 1 ? 1024 : 1536);
  const int tid = opaque_tid(wv);
  const int kp = NP == 2 ? (tid & 1) : 0;
  const int col = NP == 2 ? (tid >> 1) : tid;
  const int hl = col >> 7, v = col & 127;
  const int b = NP == 2 ? (item >> 1) : item;
  const int h = NP == 2 ? (item & 1) * 2 + hl : hl;
  const int ht = tid - hl * TPH;
  float* sm = (float*)smem_raw + hl * (12 * DK + 16);
  float* sq = sm; float* sk = sm + 4 * DK; float* sal = sm + 8 * DK; float* ssc = sm + 12 * DK;
  const size_t soff = ((size_t)(l * 128 + b) * 4 + h) * DK * 128 + (size_t)(kp * RK) * 128 + v;
  const float* st_in = (MODE == 0 ? p.in[2] : (MODE == 1 ? p.in[6] : p.in[7])) + soff;
  float* st_out = p.out + (MODE == 0 ? O_SD : (MODE == 1 ? O_SG : O_SR)) + soff;
  const float* prep = (const float*)(p.ws + WS_PREP) + (size_t)(NPR + b * 4) * PREP_LD;
  const float* proj = (const float*)(p.ws + WS_PROJ) + (size_t)(NPR + b * 4) * LDP;
  float* obuf = (float*)(p.ws + WS_OBUF) + (size_t)(NPR + b * 4) * 2048 + OB + h * 128 + v;
  f2 s[E2];
#pragma unroll
  for (int e = 0; e < E2; ++e) { s[e].x = st_in[(size_t)(2 * e) * 128]; s[e].y = st_in[(size_t)(2 * e + 1) * 128]; }
  for (int idx = ht; idx < 4 * DK; idx += TPH) {
    const int t = idx / DK, c = idx % DK;
    sq[idx] = prep[(size_t)t * PREP_LD + QOFF + h * DK + c];
    sk[idx] = prep[(size_t)t * PREP_LD + KOFF + h * DK + c];
    if (MODE == 1) sal[idx] = prep[(size_t)t * PREP_LD + P_AC + h * 64 + c];
  }
  if (MODE == 0 && ht < 8) ssc[ht] = prep[(size_t)(ht & 3) * PREP_LD + (ht < 4 ? P_AB : P_AB + 4) + h];
  float vv[4];
#pragma unroll
  for (int t = 0; t < 4; ++t)
    vv[t] = MODE == 0 ? prep[(size_t)t * PREP_LD + P_VA + h * 128 + v] : proj[(size_t)t * LDP + (MODE == 1 ? C_VC : C_VD) + h * 128 + v];
  const float gamma = 1.f - exp2f(-5.f - (float)h);
  __syncthreads();
#pragma unroll
  for (int t = 0; t < 4; ++t) {
    const float* kt = sk + t * DK + kp * RK; const float* qt = sq + t * DK + kp * RK;
    if (MODE == 0) {
      f2 ra0 = (f2){0.f, 0.f}, ra1 = ra0;
#pragma unroll
      for (int e = 0; e < E2; e += 2) {
        const float4 k4 = *(const float4*)(kt + 2 * e);
        ra0 = ((f2){k4.x, k4.y}) * s[e] + ra0; ra1 = ((f2){k4.z, k4.w}) * s[e + 1] + ra1;
      }
      float r = (ra0.x + ra0.y) + (ra1.x + ra1.y);
      r += dpp_f<0xB1>(r);
      const float a = ssc[t], be = ssc[4 + t];
      const float dd = be * (vv[t] - a * r);
      const f2 a2 = (f2){a, a}, d2 = (f2){dd, dd};
#pragma unroll
      for (int e = 0; e < E2; e += 2) {
        const float4 k4 = *(const float4*)(kt + 2 * e);
        s[e] = ((f2){k4.x, k4.y}) * d2 + a2 * s[e]; s[e + 1] = ((f2){k4.z, k4.w}) * d2 + a2 * s[e + 1];
      }
    } else if (MODE == 1) {
      const f2 v2 = (f2){vv[t], vv[t]};
#pragma unroll
      for (int e = 0; e < E2; e += 2) {
        const float4 k4 = *(const float4*)(kt + 2 * e);
        const float4 a4 = *(const float4*)(sal + t * DK + 2 * e);
        s[e] = ((f2){k4.x, k4.y}) * v2 + ((f2){a4.x, a4.y}) * s[e]; s[e + 1] = ((f2){k4.z, k4.w}) * v2 + ((f2){a4.z, a4.w}) * s[e + 1];
      }
    } else {
      const f2 v2 = (f2){vv[t], vv[t]}, g2 = (f2){gamma, gamma};
#pragma unroll
      for (int e = 0; e < E2; e += 2) {
        const float4 k4 = *(const float4*)(kt + 2 * e);
        s[e] = ((f2){k4.x, k4.y}) * v2 + g2 * s[e]; s[e + 1] = ((f2){k4.z, k4.w}) * v2 + g2 * s[e + 1];
      }
    }
    f2 oa0 = (f2){0.f, 0.f}, oa1 = oa0;
#pragma unroll
    for (int e = 0; e < E2; e += 2) {
      const float4 q4 = *(const float4*)(qt + 2 * e);
      oa0 = ((f2){q4.x, q4.y}) * s[e] + oa0; oa1 = ((f2){q4.z, q4.w}) * s[e + 1] + oa1;
    }
    float o = (oa0.x + oa0.y) + (oa1.x + oa1.y);
    if (NP == 2) o += dpp_f<0xB1>(o);
    if (kp == 0) obuf[(size_t)t * 2048] = o;
  }
#pragma unroll
  for (int e = 0; e < E2; ++e) { st_out[(size_t)(2 * e) * 128] = s[e].x; st_out[(size_t)(2 * e + 1) * 128] = s[e].y; }
  __syncthreads();
}

__device__ __forceinline__ void scan_lru_prompt(CP& p, int l, int b, int cgp, int wv) {
  extern __shared__ __attribute__((aligned(16))) unsigned char smem_raw[];
  float* sA = (float*)smem_raw; float* sB = sA + 512;
  const int tid = opaque_tid(wv);
  const int ch = tid & 31, seg = tid >> 5, c = cgp * 32 + ch;
  const float* prep = (const float*)(p.ws + WS_PREP) + (size_t)(b * LP + seg * 129) * PREP_LD + c;
  float* obuf = (float*)(p.ws + WS_OBUF) + (size_t)(b * LP + seg * 129) * 2048 + 512 + c;
  float A = 1.f, B = 0.f;
#pragma unroll 1
  for (int t0 = 0; t0 < 129; t0 += 43) {
    float av[43], bv[43];
#pragma unroll
    for (int i = 0; i < 43; ++i) { av[i] = prep[(size_t)(t0 + i) * PREP_LD + P_LA]; bv[i] = prep[(size_t)(t0 + i) * PREP_LD + P_LB]; }
#pragma unroll
    for (int i = 0; i < 43; ++i) { B = av[i] * B + bv[i]; A *= av[i]; }
  }
  sA[seg * 32 + ch] = A; sB[seg * 32 + ch] = B;
  __syncthreads();
  float h = 0.f;
  for (int s2 = 0; s2 < seg; ++s2) h = sA[s2 * 32 + ch] * h + sB[s2 * 32 + ch];
#pragma unroll 1
  for (int t0 = 0; t0 < 129; t0 += 43) {
    float av[43], bv[43];
#pragma unroll
    for (int i = 0; i < 43; ++i) { av[i] = prep[(size_t)(t0 + i) * PREP_LD + P_LA]; bv[i] = prep[(size_t)(t0 + i) * PREP_LD + P_LB]; }
#pragma unroll
    for (int i = 0; i < 43; ++i) { h = av[i] * h + bv[i]; obuf[(size_t)(t0 + i) * 2048] = h; }
  }
  if (seg == 15) p.out[O_PL + (size_t)(l * 4 + b) * 512 + c] = h;
  __syncthreads();
}

__device__ __forceinline__ void scan_lru_sample(CP& p, int l, int b, int wv) {
  const int c = opaque_tid(wv);
  const float* prep = (const float*)(p.ws + WS_PREP) + (size_t)(NPR + b * 4) * PREP_LD;
  float* obuf = (float*)(p.ws + WS_OBUF) + (size_t)(NPR + b * 4) * 2048 + 512 + c;
  float h = p.in[4][(size_t)(l * 128 + b) * 512 + c];
#pragma unroll
  for (int t = 0; t < 4; ++t) { h = prep[(size_t)t * PREP_LD + P_LA + c] * h + prep[(size_t)t * PREP_LD + P_LB + c]; obuf[(size_t)t * 2048] = h; }
  p.out[O_SL + (size_t)(l * 128 + b) * 512 + c] = h;
}

__device__ __forceinline__ void scan_item2(CP& p, int l, int k, int wv) {
  if (k < 64) scan_lru_prompt(p, l, k >> 4, k & 15, wv);
  else if (k < 320) scan_sample<0>(p, l, k - 64, wv);
  else if (k < 448) scan_sample<1>(p, l, k - 320, wv);
  else if (k < 576) scan_sample<2>(p, l, k - 448, wv);
  else scan_lru_sample(p, l, k - 576, wv);
}

__device__ __forceinline__ void phase_scan(CP& p, int l, int wv) {
  extern __shared__ __attribute__((aligned(16))) unsigned char smem_raw[];
  float* sm = (float*)smem_raw;
  const int G = gridDim.x;
  const int tid = opaque_tid(wv);
  const int role = tid >> 8, rt = tid & 255;
#pragma unroll 1
  for (int it = blockIdx.x; it < 32; it += G) {
    if (role == 0) scan_prompt_delta_mfma(p, l, it >> 1, it & 1, sm, rt);
    else { for (int i = 0; i < NST + 1; ++i) __syncthreads(); }
    __syncthreads();
  }
#pragma unroll 1
  for (int it = blockIdx.x < 32 ? blockIdx.x + ((32 + G - 1 - blockIdx.x) / G) * G : blockIdx.x; it < 64; it += G) {
    const int i2 = it - 32;
    if (role == 0) scan_prompt_mfma<1>(p, l, i2 >> 1, i2 & 1, sm, rt);
    else scan_prompt_mfma<2>(p, l, i2 >> 1, i2 & 1, sm + 10240, rt);
    __syncthreads();
  }
  if (G >= 128) {
#pragma unroll 1
    for (int k = (int)blockIdx.x - 64; k >= 0 && k < 704; k += G - 64) scan_item2(p, l, k, wv);
    __syncthreads();
  } else {
#pragma unroll 1
    for (int k = blockIdx.x; k < 704; k += G) scan_item2(p, l, k, wv);
    __syncthreads();
  }
  __syncthreads();
}

__device__ __forceinline__ void phase_post(CP& p, int l, int wv) {
  const int tid = opaque_tid(wv), lane = tid & 63, w = tid >> 6;
  const float* obuf = (const float*)(p.ws + WS_OBUF);
  const float* proj = (const float*)(p.ws + WS_PROJ);
  uint2* mix = (uint2*)(p.ws + WS_MIX);
  const unsigned short* gb16 = (const unsigned short*)(p.ws + WS_GB16);
  const float4 na = *(const float4*)(p.in[14] + l * 128 + (lane & 31) * 4);
  const float4 nc = *(const float4*)(p.in[24] + l * 128 + (lane & 31) * 4);
  for (int r = blockIdx.x * 8 + w; r < MROWS; r += gridDim.x * 8) {
#pragma unroll 4
    for (int it = 0; it < 8; ++it) {
      float4 x = *(const float4*)(obuf + (size_t)r * 2048 + it * 256 + lane * 4);
      const int ca = C_GATE + it * 256 + lane * 4;
      float4 g;
      if (ca >= GCOL0) {
        const uint2 u = *(const uint2*)(gb16 + (size_t)r * 2048 + (ca - GCOL0));
        g.x = __uint_as_float(u.x << 16); g.y = __uint_as_float(u.x & 0xffff0000u); g.z = __uint_as_float(u.y << 16); g.w = __uint_as_float(u.y & 0xffff0000u);
      } else g = *(const float4*)(proj + (size_t)r * LDP + ca);
      const int ty = it >> 1;
      if (ty != 1) {
        float s = x.x * x.x + x.y * x.y + x.z * x.z + x.w * x.w;
        s = row16_allsum(s);
        s += __builtin_bit_cast(float, __builtin_amdgcn_update_dpp(0, __builtin_bit_cast(int, s), 0x142, 0xa, 0xf, false));
        const float sA = __builtin_bit_cast(float, __builtin_amdgcn_readlane(__builtin_bit_cast(int, s), 31));
        const float sB = __builtin_bit_cast(float, __builtin_amdgcn_readlane(__builtin_bit_cast(int, s), 63));
        const float ss = lane < 32 ? sA : sB;
        const float sc = __builtin_amdgcn_rsqf(ss * (1.f / 128.f) + 1e-6f);
        x.x *= sc; x.y *= sc; x.z *= sc; x.w *= sc;
        if (ty == 0) { x.x *= na.x; x.y *= na.y; x.z *= na.z; x.w *= na.w; }
        else if (ty == 2) { x.x *= nc.x; x.y *= nc.y; x.z *= nc.z; x.w *= nc.w; }
      }
      mix[(size_t)r * 512 + it * 64 + lane] = make_uint2(pack2(x.x * siluf_(g.x), x.y * siluf_(g.y)), pack2(x.z * siluf_(g.z), x.w * siluf_(g.w)));
    }
  }
}

__device__ __forceinline__ void phase_final(CP& p, int wv) {
  const int tid = opaque_tid(wv), lane = tid & 63, w = tid >> 6;
  const float* H = (const float*)(p.ws + WS_H);
  const float4* fw = (const float4*)p.in[26];
  for (int r = blockIdx.x * 8 + w; r < MROWS; r += gridDim.x * 8) {
    float* dst;
    if (r < NPR) { const int b = r / LP, t = r % LP; if (t < 16) continue; dst = p.out + O_YP + ((size_t)b * 2048 + (t - 16)) * D; }
    else dst = p.out + O_YS + (size_t)(r - NPR) * D;
    const float4* src = (const float4*)(H + (size_t)r * D);
    float4 v[8]; float ss = 0.f;
#pragma unroll
    for (int i = 0; i < 8; ++i) v[i] = src[lane + 64 * i];
    if (r >= 8192) {
      const float* pb = (const float*)(p.ws + WS_PB) + ((size_t)(((r >> 8) - 32) * 8) * 8) * 65536 + (size_t)(r & 255) * 256 + lane * 4;
#pragma unroll
      for (int i = 0; i < 8; ++i)
#pragma unroll
        for (int ch = 0; ch < 8; ++ch) { const float4 a = *(const float4*)(pb + (size_t)(i * 8 + ch) * 65536); v[i].x += a.x; v[i].y += a.y; v[i].z += a.z; v[i].w += a.w; }
    }
#pragma unroll
    for (int i = 0; i < 8; ++i) ss += v[i].x * v[i].x + v[i].y * v[i].y + v[i].z * v[i].z + v[i].w * v[i].w;
    ss = wave_allsum(ss);
    const float sc = __builtin_amdgcn_rsqf(ss * (1.f / 2048.f) + 1e-6f);
#pragma unroll
    for (int i = 0; i < 8; ++i) {
      const float4 wv = fw[lane + 64 * i];
      ((float4*)dst)[lane + 64 * i] = make_float4(v[i].x * sc * wv.x, v[i].y * sc * wv.y, v[i].z * sc * wv.z, v[i].w * sc * wv.w);
    }
  }
}

#define XB_TMO      128
#define XB_XCNT(j)  (256  + 64 * (j))
#define XB_XSUB(j)  (1280 + 64 * (j))
#define XB_XGEN(j)  (2304 + 64 * (j))
#define XB_TOP      3328
#define XB_TOPGEN   3392
#define XCD_BAR_WORDS 3456
#define XB_SPIN_CAP (1u << 22)
#define LAS __attribute__((address_space(3)))
__device__ __forceinline__ unsigned xb_ld(unsigned* p)              { return __hip_atomic_load(p, __ATOMIC_RELAXED, __HIP_MEMORY_SCOPE_AGENT); }
__device__ __forceinline__ unsigned xb_add(unsigned* p, unsigned v) { return __hip_atomic_fetch_add(p, v, __ATOMIC_RELAXED, __HIP_MEMORY_SCOPE_AGENT); }
__device__ __forceinline__ unsigned xb_xcc_id() { return (unsigned)__builtin_amdgcn_s_getreg((3 << 11) | 20) & 0xFu; }
#define XB_SPIN(cond, bar) do { unsigned _sp = 0; while (cond) { __builtin_amdgcn_s_sleep(1); \
    if ((++_sp & 255u) == 0u) { if (xb_ld(&(bar)[XB_TMO])) break; if (_sp > XB_SPIN_CAP) { atomicAdd(&(bar)[XB_TMO], 1u); break; } } } } while (0)
__device__ __forceinline__ void xcd_barrier_complete(unsigned* bar, unsigned x, unsigned& nloc, unsigned& nx) {
  const unsigned G = gridDim.x;
  unsigned sum, cnt, mine, sp = 0u;
  for (;;) {
    sum = 0u; cnt = 0u; mine = 0u;
#pragma unroll
    for (unsigned j = 0; j < 16; ++j) { const unsigned c = xb_ld(&bar[XB_XCNT(j)]); sum += c; cnt += (c > 0u) ? 1u : 0u; mine = (j == x) ? c : mine; }
    if (sum == G) break;
    __builtin_amdgcn_s_sleep(1);
    if ((++sp & 255u) == 0u) { if (xb_ld(&bar[XB_TMO])) break; if (sp > XB_SPIN_CAP) { atomicAdd(&bar[XB_TMO], 1u); break; } }
  }
  nloc = mine > 0u ? mine : 1u; nx = cnt > 0u ? cnt : 1u;
}
__device__ __forceinline__ void fast_grid_sync(unsigned* bar, int wv) {
  extern __shared__ __attribute__((aligned(16))) unsigned char smem_raw[];
  asm volatile("s_waitcnt vmcnt(0)" ::: "memory");
  __syncthreads();
  if (wv == 0) {
    if (opaque_tid(wv) == 0) {
      volatile LAS unsigned* st = (volatile LAS unsigned*)(smem_raw + 131072);
      __builtin_amdgcn_s_waitcnt(0);
      const unsigned x = xb_xcc_id();
      unsigned nloc = st[0], nx = st[1];
      if (nloc == 0u) { xcd_barrier_complete(bar, x, nloc, nx); st[0] = nloc; st[1] = nx; }
      const unsigned old = xb_add(&bar[XB_XSUB(x)], 1u);
      const unsigned gen = old / nloc;
      if (old + 1u == (gen + 1u) * nloc) {
        __builtin_amdgcn_fence(__ATOMIC_RELEASE, "agent");
        asm volatile("s_waitcnt vmcnt(0)" ::: "memory");
        const unsigned og = xb_add(&bar[XB_TOP], 1u);
        const unsigned tg = og / nx;
        if (og + 1u == (tg + 1u) * nx) xb_add(&bar[XB_TOPGEN], 1u);
        else XB_SPIN(xb_ld(&bar[XB_TOPGEN]) == tg, bar);
        __builtin_amdgcn_fence(__ATOMIC_ACQUIRE, "agent");
        xb_add(&bar[XB_XGEN(x)], 1u);
        asm volatile("s_waitcnt vmcnt(0)" ::: "memory");
      } else {
        XB_SPIN(xb_ld(&bar[XB_XGEN(x)]) == gen, bar);
        __builtin_amdgcn_fence(__ATOMIC_ACQUIRE, "agent");
        asm volatile("s_waitcnt vmcnt(0)" ::: "memory");
      }
    }
  }
  __syncthreads();
}

__global__ void __launch_bounds__(NTHR) mega(P p_) {
  cg::grid_group grid = cg::this_grid();
  const int wv = __builtin_amdgcn_readfirstlane((int)(threadIdx.x >> 6));
#define GSYNC(j_) fast_grid_sync((unsigned*)((*getp()).ws + WS_BAR), wv)
  { extern __shared__ __attribute__((aligned(16))) unsigned char smem_raw[];
    if (wv == 0 && opaque_tid(wv) == 0) { volatile LAS unsigned* st = (volatile LAS unsigned*)(smem_raw + 131072); st[0] = 0u; st[1] = 0u;
      (void)xb_add(&((unsigned*)((*getp()).ws + WS_BAR))[XB_XCNT(xb_xcc_id())], 1u); }
    __syncthreads(); }
  phase_convert(*getp(), wv);
  if ((*getp()).pad != 0) grid.sync();
  GSYNC(0);
#pragma unroll 1
  for (int l = 0; l < 4; ++l) {
    phase_norm(*getp(), wv, l > 0);
    GSYNC(1);
    { CP& p = *getp();
      phase_gemm<0>((const bf16*)(p.ws + WS_XN), (const bf16*)(p.ws + WS_WTIN) + (size_t)l * LDW * 2048, (float*)(p.ws + WS_PROJ), p.mpad, p.ldp, wv, p.ldq, (unsigned short*)(p.ws + WS_GB16)); }
    {
      const int G_ = gridDim.x, nt4 = 875 - 3 * G_;
      if (l < 3 && G_ == 256 && (int)blockIdx.x >= nt4) convert_weights(*getp(), wv, (l + 1) * CV_TL, (l + 2) * CV_TL, (int)blockIdx.x - nt4, G_ - nt4);
      else if (l < 3 && G_ != 256) convert_weights(*getp(), wv, (l + 1) * CV_TL, (l + 2) * CV_TL, blockIdx.x, G_); }
    GSYNC(2);
    phase_prep(*getp(), l, wv);
    GSYNC(3);
    phase_prep2(*getp(), wv);
    GSYNC(4);
    phase_scan(*getp(), l, wv);
    GSYNC(5);
    phase_post(*getp(), l, wv);
    GSYNC(6);
    { CP& p = *getp();
      phase_gemm_out((const bf16*)(p.ws + WS_MIX), (const bf16*)(p.ws + WS_WTOUT) + (size_t)l * 2048 * 2048, (float*)(p.ws + WS_H), (float*)(p.ws + WS_PB), p.mpad, p.dm, wv); }
    GSYNC(7);
  }
  phase_final(*getp(), wv);
}

#undef GSYNC
extern "C" void kernel_launch(void* const* d_in, const int* in_sizes, int n_in, void* d_out, int out_size, void* d_ws, size_t ws_size,
                              hipStream_t stream) {
  static int grid = 0;
  if (grid == 0) {
    int dev = 0, cus = 0, per_cu = 0;
    hipGetDevice(&dev);
    hipDeviceGetAttribute(&cus, hipDeviceAttributeMultiprocessorCount, dev);
    hipFuncSetAttribute((const void*)mega, hipFuncAttributeMaxDynamicSharedMemorySize, LDS_BYTES);
    hipOccupancyMaxActiveBlocksPerMultiprocessor(&per_cu, (const void*)mega, NTHR, LDS_BYTES);
    if (per_cu < 1) per_cu = 1;
    if (per_cu > 1) per_cu = 1;
    grid = cus * per_cu;
    if (ws_size < WS_END) { fprintf(stderr, "workspace too small: %zu < %zu\n", ws_size, (size_t)WS_END); }
  }
  P p{};
  for (int i = 0; i < 27; ++i) p.in[i] = (const float*)d_in[i];
  p.out = (float*)d_out;
  p.ws = (unsigned char*)d_ws;
  p.mpad = MPAD; p.ldp = LDW; p.dm = D; p.pad = 0; p.ldq = LDP; p.pad2 = 0;
  (void)hipMemsetAsync((unsigned char*)d_ws + WS_BAR, 0, 16384, stream);
  void* args[] = {&p};
  hipError_t e = hipLaunchCooperativeKernel((const void*)mega, dim3(grid), dim3(NTHR), args, LDS_BYTES, stream);
  if (e != hipSuccess) fprintf(stderr, "cooperative launch failed: %s (grid %d)\n", hipGetErrorString(e), grid);
}
```
